# Optimizing an MI355X kernel written in HIP

```python
import math
import jax, jax.numpy as jnp
from jax import lax
import numpy as np

D_MODEL = 2048
BATCH = 2
SEQ = 8192
DEPTH = 4

CHUNK = 64
HEAD_DIM = 128
RET_HEADS = 6
GLA_HEADS = 4
GLA_DK = 64
GLA_DV = 128
GLA_RANK = 16
GLA_TAU = 16.0
ATT_HEADS = 6
ATT_BAND_CHUNKS = 8
MAX_REL = 128
N_GROUPS = 4
EXPERTS_PER_GROUP = 8
TOP_K = 2
EXPERT_FF = 256
PLE_DIM = 256
EPS = 1e-6

RET_W = RET_HEADS * HEAD_DIM
GLA_QK = GLA_HEADS * GLA_DK
GLA_V = GLA_HEADS * GLA_DV
ATT_W = ATT_HEADS * HEAD_DIM
D_MIX = RET_W + GLA_V + ATT_W
SPLIT_SIZES = (RET_W, RET_W, RET_W, RET_W, GLA_QK, GLA_QK, GLA_V, GLA_V, GLA_RANK, ATT_W, ATT_W, ATT_W)
SPLIT_POINTS = tuple(sum(SPLIT_SIZES[:i + 1]) for i in range(len(SPLIT_SIZES) - 1))
D_IN = sum(SPLIT_SIZES)

kernel_name = "hybrid_ret_gla_chunkattn_hmoe_ple"

F32 = jnp.float32


def rms_norm(x, g):
    x32 = x.astype(F32)
    y = x32 * lax.rsqrt(jnp.mean(x32 * x32, axis=-1, keepdims=True) + EPS)
    return (y * g.astype(F32)).astype(x.dtype)


def head_group_norm(o):
    mu = jnp.mean(o, axis=-1, keepdims=True)
    var = jnp.mean(jnp.square(o - mu), axis=-1, keepdims=True)
    return (o - mu) * lax.rsqrt(var + EPS)


def head_rms_norm(o):
    return o * lax.rsqrt(jnp.mean(o * o, axis=-1, keepdims=True) + EPS)


def to_chunks(t):
    B, S, H, d = t.shape
    return t.reshape(B, S // CHUNK, CHUNK, H, d).transpose(0, 3, 1, 2, 4)


def from_chunks(t):
    B, H, N, C, d = t.shape
    return t.transpose(0, 2, 3, 1, 4).reshape(B, N * C, H, d)


def rotary(t, pos):
    half = t.shape[-1] // 2
    inv = 1.0 / (10000.0 ** (jnp.arange(half, dtype=F32) / half))
    ang = pos.astype(F32)[:, None] * inv[None, :]
    cos = jnp.cos(ang)[None, :, None, :]
    sin = jnp.sin(ang)[None, :, None, :]
    t32 = t.astype(F32)
    t1, t2 = t32[..., :half], t32[..., half:]
    return jnp.concatenate([t1 * cos - t2 * sin, t1 * sin + t2 * cos], axis=-1)


def retention(q, k, v, pos):
    H, d = q.shape[2], q.shape[3]
    qc = to_chunks(rotary(q, pos))
    kc = to_chunks(rotary(k, pos) * (d ** -0.5))
    vc = to_chunks(v.astype(F32))
    log_gamma = jnp.log(1.0 - 2.0 ** (-5.0 - jnp.arange(H, dtype=F32)))
    j = jnp.arange(CHUNK, dtype=F32)
    intra_decay = jnp.exp(log_gamma[:, None, None] * jnp.abs(j[:, None] - j[None, :]))
    zeta = jnp.exp(log_gamma[:, None] * (CHUNK - 1.0 - j[None, :]))
    xi = jnp.exp(log_gamma[:, None] * (j[None, :] + 1.0))
    chunk_decay = jnp.exp(log_gamma * CHUNK)

    scores = jnp.einsum('bhncd,bhnld->bhncl', qc, kc) * intra_decay[None, :, None]
    intra = jnp.einsum('bhncl,bhnle->bhnce', scores, vc)
    upd = jnp.einsum('bhnld,bhnle,hl->bhnde', kc, vc, zeta)

    def step(state, u):
        return chunk_decay[None, :, None, None] * state + u, state

    _, state_prev = lax.scan(step, jnp.zeros_like(upd[:, :, 0]), jnp.moveaxis(upd, 2, 0))
    state_prev = jnp.moveaxis(state_prev, 0, 2)
    cross = jnp.einsum('bhncd,bhnde->bhnce', qc, state_prev) * xi[None, :, None, :, None]
    return from_chunks(intra + cross)


def gla(q, k, v, log_alpha):
    dk = q.shape[-1]
    qc = to_chunks(q.astype(F32) * (dk ** -0.5))
    kc = to_chunks(k.astype(F32))
    vc = to_chunks(v.astype(F32))
    b = jnp.cumsum(to_chunks(log_alpha.astype(F32)), axis=3)
    b_last = b[:, :, :, -1:, :]
    q_in = qc * jnp.exp(b)
    k_in = kc * jnp.exp(-b)
    causal = jnp.tril(jnp.ones((CHUNK, CHUNK), dtype=bool))
    a = jnp.where(causal, jnp.einsum('bhncd,bhnld->bhncl', q_in, k_in), 0.0)
    intra = jnp.einsum('bhncl,bhnle->bhnce', a, vc)
    upd = jnp.einsum('bhnld,bhnle->bhnde', kc * jnp.exp(b_last - b), vc)
    g = jnp.exp(b_last[:, :, :, 0, :])

    def step(state, inp):
        gc, u = inp
        return gc[..., None] * state + u, state

    _, state_prev = lax.scan(step, jnp.zeros_like(upd[:, :, 0]),
                             (jnp.moveaxis(g, 2, 0), jnp.moveaxis(upd, 2, 0)))
    state_prev = jnp.moveaxis(state_prev, 0, 2)
    cross = jnp.einsum('bhncd,bhnde->bhnce', q_in, state_prev)
    return from_chunks(intra + cross)


def chunk_band_attention(q, k, v, rel_bias):
    B, S, H, d = q.shape
    N = S // CHUNK
    W = ATT_BAND_CHUNKS + 1
    qc = to_chunks(q) * (d ** -0.5)
    kc, vc = to_chunks(k), to_chunks(v)
    pad = ((0, 0), (0, 0), (ATT_BAND_CHUNKS, 0), (0, 0), (0, 0))
    kp, vp = jnp.pad(kc, pad), jnp.pad(vc, pad)
    k_band = jnp.stack([kp[:, :, o:o + N] for o in range(W)], axis=3).reshape(B, H, N, W * CHUNK, d)
    v_band = jnp.stack([vp[:, :, o:o + N] for o in range(W)], axis=3).reshape(B, H, N, W * CHUNK, d)
    s = jnp.einsum('bhncd,bhnkd->bhnck', qc, k_band).astype(F32)
    rel = (ATT_BAND_CHUNKS * CHUNK + jnp.arange(CHUNK))[:, None] - jnp.arange(W * CHUNK)[None, :]
    bias = rel_bias.astype(F32)[:, jnp.clip(rel, -MAX_REL, MAX_REL) + MAX_REL]
    valid = (jnp.arange(N)[:, None] + jnp.arange(W)[None, :] - ATT_BAND_CHUNKS) >= 0
    valid = jnp.repeat(valid, CHUNK, axis=1)
    s = jnp.where(valid[None, None, :, None, :], s + bias[None, :, None], -1e30)
    probs = jax.nn.softmax(s, axis=-1)
    out = jnp.einsum('bhnck,bhnkd->bhncd', probs, v_band.astype(F32))
    return from_chunks(out)


def mixing_block(x, g_mix, w_in, gla_w_alpha, gla_b_alpha, rel_bias, mix_scale, w_out, pos):
    B, S, _ = x.shape
    h = rms_norm(x, g_mix)
    z = h @ w_in
    rq, rk, rv, rg, gq, gk, gv, gg, ga, aq, ak, av = jnp.split(z, SPLIT_POINTS, axis=-1)
    heads = lambda t, n: t.reshape(B, S, n, -1)
    o_ret = head_group_norm(retention(heads(rq, RET_HEADS), heads(rk, RET_HEADS), heads(rv, RET_HEADS), pos))
    o_ret = o_ret.reshape(B, S, RET_W) * jax.nn.silu(rg.astype(F32))
    log_alpha = jax.nn.log_sigmoid((ga @ gla_w_alpha + gla_b_alpha).astype(F32)) / GLA_TAU
    o_gla = head_rms_norm(gla(heads(gq, GLA_HEADS), heads(gk, GLA_HEADS), heads(gv, GLA_HEADS),
                              log_alpha.reshape(B, S, GLA_HEADS, GLA_DK)))
    o_gla = o_gla.reshape(B, S, GLA_V) * jax.nn.silu(gg.astype(F32))
    o_att = head_rms_norm(chunk_band_attention(heads(aq, ATT_HEADS), heads(ak, ATT_HEADS),
                                               heads(av, ATT_HEADS), rel_bias)).reshape(B, S, ATT_W)
    y = jnp.concatenate([o_ret, o_gla, o_att], axis=-1) * mix_scale.astype(F32)
    return y.astype(x.dtype) @ w_out


def hierarchical_moe(h, w_rg, b_rg, w_re, b_re, w_gate, w_up, w_down):
    gp = jax.nn.softmax((h @ w_rg + b_rg).astype(F32), axis=-1)
    p_group, g_idx = lax.top_k(gp, 1)
    el = (jnp.einsum('bsd,dge->bsge', h, w_re) + b_re).astype(F32)
    el = jnp.take_along_axis(el, g_idx[..., None], axis=2)[:, :, 0]
    w_top, e_idx = lax.top_k(jax.nn.softmax(el, axis=-1), TOP_K)
    w_top = w_top / jnp.sum(w_top, axis=-1, keepdims=True)
    w_e = jnp.sum(jax.nn.one_hot(e_idx, EXPERTS_PER_GROUP, dtype=F32) * w_top[..., None], axis=2)
    comb = jax.nn.one_hot(g_idx[..., 0], N_GROUPS, dtype=F32)[..., None] * (p_group * w_e)[:, :, None, :]
    comb = comb.astype(h.dtype)
    y = jnp.zeros_like(h)
    for gi in range(N_GROUPS):
        a = jnp.einsum('bsd,edf->bsef', h, w_gate[gi])
        u = jnp.einsum('bsd,edf->bsef', h, w_up[gi])
        hid = jax.nn.silu(a) * u * comb[:, :, gi, :, None]
        y = y + jnp.einsum('bsef,efd->bsd', hid, w_down[gi])
    return y


def setup_inputs(seed: int = 0) -> dict:
    key = jax.random.key(seed)
    ks = jax.random.split(key, 21)
    nrm = lambda k, shape, scale: jax.random.normal(k, shape, F32) * scale
    gain = lambda k, shape: 1.0 + 0.02 * jax.random.normal(k, shape, F32)
    G, E, F = N_GROUPS, EXPERTS_PER_GROUP, EXPERT_FF
    return {
        "x": nrm(ks[0], (BATCH, SEQ, D_MODEL), 1.0),
        "p": nrm(ks[1], (DEPTH, BATCH, SEQ, PLE_DIM), 1.0),
        "g_mix": gain(ks[2], (DEPTH, D_MODEL)),
        "w_in": nrm(ks[3], (DEPTH, D_MODEL, D_IN), D_MODEL ** -0.5),
        "gla_w_alpha": nrm(ks[4], (DEPTH, GLA_RANK, GLA_QK), GLA_RANK ** -0.5),
        "gla_b_alpha": nrm(ks[5], (DEPTH, GLA_QK), 0.1),
        "rel_bias": nrm(ks[6], (DEPTH, ATT_HEADS, 2 * MAX_REL + 1), 0.2),
        "mix_scale": gain(ks[7], (DEPTH, D_MIX)),
        "w_out": nrm(ks[8], (DEPTH, D_MIX, D_MODEL), D_MIX ** -0.5),
        "g_ffn": gain(ks[9], (DEPTH, D_MODEL)),
        "w_router_group": nrm(ks[10], (DEPTH, D_MODEL, G), D_MODEL ** -0.5),
        "b_router_group": nrm(ks[11], (DEPTH, G), 0.01),
        "w_router_expert": nrm(ks[12], (DEPTH, D_MODEL, G, E), D_MODEL ** -0.5),
        "b_router_expert": nrm(ks[13], (DEPTH, G, E), 0.01),
        "w_expert_gate": nrm(ks[14], (DEPTH, G, E, D_MODEL, F), D_MODEL ** -0.5),
        "w_expert_up": nrm(ks[15], (DEPTH, G, E, D_MODEL, F), D_MODEL ** -0.5),
        "w_expert_down": nrm(ks[16], (DEPTH, G, E, F, D_MODEL), F ** -0.5),
        "g_ple": gain(ks[17], (DEPTH, D_MODEL)),
        "w_ple_gate": nrm(ks[18], (DEPTH, D_MODEL, D_MODEL), D_MODEL ** -0.5),
        "w_ple_proj": nrm(ks[19], (DEPTH, PLE_DIM, D_MODEL), PLE_DIM ** -0.5),
        "g_final": gain(ks[20], (D_MODEL,)),
    }


def reference(x, p, g_mix, w_in, gla_w_alpha, gla_b_alpha, rel_bias, mix_scale, w_out, g_ffn,
              w_router_group, b_router_group, w_router_expert, b_router_expert,
              w_expert_gate, w_expert_up, w_expert_down, g_ple, w_ple_gate, w_ple_proj, g_final):
    pos = jnp.arange(x.shape[1], dtype=jnp.int32)
    for i in range(DEPTH):
        x = x + mixing_block(x, g_mix[i], w_in[i], gla_w_alpha[i], gla_b_alpha[i], rel_bias[i],
                             mix_scale[i], w_out[i], pos)
        x = x + hierarchical_moe(rms_norm(x, g_ffn[i]), w_router_group[i], b_router_group[i],
                                 w_router_expert[i], b_router_expert[i],
                                 w_expert_gate[i], w_expert_up[i], w_expert_down[i])
        gate = jax.nn.sigmoid(rms_norm(x, g_ple[i]) @ w_ple_gate[i])
        x = x + gate * (p[i] @ w_ple_proj[i])
    return rms_norm(x, g_final)
```

```cpp
#include <hip/hip_runtime.h>
#include <math.h>

namespace {
constexpr int B_ = 2, S_ = 8192, T_ = B_ * S_, D_ = 2048, DEPTH_ = 4, DIN = 6928, CH = 64, NCH = S_ / CH;
constexpr int RET_H = 6, GLA_H = 4, ATT_H = 6, HD = 128, GDK = 64, GDV = 128, GRANK = 16;
constexpr int O_RQ = 0, O_RK = 768, O_RV = 1536, O_RG = 2304, O_GQ = 3072, O_GK = 3328, O_GV = 3584, O_GG = 4096, O_GA = 4608, O_AQ = 4624, O_AK = 5392, O_AV = 6160;
constexpr int NG = 4, NE = 8, FF = 256, PLE = 256;
constexpr float EPS = 1e-6f;

__device__ __forceinline__ float block_sum(float v, float* red) {
    for (int o = 32; o >= 1; o >>= 1) v += __shfl_xor(v, o);
    const int w = threadIdx.x >> 6, nw = blockDim.x >> 6;
    __syncthreads();
    if ((threadIdx.x & 63) == 0) red[w] = v;
    __syncthreads();
    float s = 0.f;
    for (int i = 0; i < nw; ++i) s += red[i];
    return s;
}
__device__ __forceinline__ float silu_f(float x) { return x / (1.f + expf(-x)); }

__global__ void k_rmsnorm(const float* __restrict__ x, const float* __restrict__ g, float* __restrict__ h) {
    __shared__ float red[16];
    const size_t row = blockIdx.x;
    const float* xr = x + row * D_;
    float v[8], ss = 0.f;
    for (int i = 0; i < 8; ++i) { v[i] = xr[threadIdx.x + 256 * i]; ss += v[i] * v[i]; }
    ss = block_sum(ss, red);
    const float rs = rsqrtf(ss / D_ + EPS);
    for (int i = 0; i < 8; ++i) h[row * D_ + threadIdx.x + 256 * i] = v[i] * rs * g[threadIdx.x + 256 * i];
}

__global__ __launch_bounds__(256) void k_sgemm(const float* __restrict__ A, const float* __restrict__ Bm, float* __restrict__ C, int M, int N, int K, int lda, int ldb, int ldc) {
    __shared__ float As[16][128 + 4];
    __shared__ float Bs[16][128 + 4];
    const int tid = threadIdx.x, tx = tid & 15, ty = tid >> 4;
    const int m0 = blockIdx.y * 128, n0 = blockIdx.x * 128;
    float acc[8][8];
    for (int i = 0; i < 8; ++i) for (int j = 0; j < 8; ++j) acc[i][j] = 0.f;
    const int ar = tid >> 1, ak = (tid & 1) * 8;
    const int bk = tid >> 4, bn = (tid & 15) * 8;
    for (int k0 = 0; k0 < K; k0 += 16) {
        const float4 a0 = *(const float4*)(A + (size_t)(m0 + ar) * lda + k0 + ak);
        const float4 a1 = *(const float4*)(A + (size_t)(m0 + ar) * lda + k0 + ak + 4);
        float4 b0 = make_float4(0, 0, 0, 0), b1 = b0;
        if (n0 + bn + 8 <= N) { b0 = *(const float4*)(Bm + (size_t)(k0 + bk) * ldb + n0 + bn); b1 = *(const float4*)(Bm + (size_t)(k0 + bk) * ldb + n0 + bn + 4); }
        __syncthreads();
        As[ak + 0][ar] = a0.x; As[ak + 1][ar] = a0.y; As[ak + 2][ar] = a0.z; As[ak + 3][ar] = a0.w;
        As[ak + 4][ar] = a1.x; As[ak + 5][ar] = a1.y; As[ak + 6][ar] = a1.z; As[ak + 7][ar] = a1.w;
        *(float4*)&Bs[bk][bn] = b0; *(float4*)&Bs[bk][bn + 4] = b1;
        __syncthreads();
#pragma unroll
        for (int kk = 0; kk < 16; ++kk) {
            float a[8], b[8];
            *(float4*)&a[0] = *(const float4*)&As[kk][ty * 4]; *(float4*)&a[4] = *(const float4*)&As[kk][64 + ty * 4];
            *(float4*)&b[0] = *(const float4*)&Bs[kk][tx * 4]; *(float4*)&b[4] = *(const float4*)&Bs[kk][64 + tx * 4];
#pragma unroll
            for (int i = 0; i < 8; ++i)
#pragma unroll
                for (int j = 0; j < 8; ++j) acc[i][j] += a[i] * b[j];
        }
    }
    for (int i = 0; i < 8; ++i) {
        const int r = m0 + (i < 4 ? ty * 4 + i : 64 + ty * 4 + i - 4);
        for (int jh = 0; jh < 2; ++jh) {
            const int c = n0 + jh * 64 + tx * 4;
            if (c + 4 <= N) *(float4*)(C + (size_t)r * ldc + c) = make_float4(acc[i][jh * 4 + 0], acc[i][jh * 4 + 1], acc[i][jh * 4 + 2], acc[i][jh * 4 + 3]);
        }
    }
}

__global__ void k_rotary(float* __restrict__ z) {
    const int m = blockIdx.x, h = threadIdx.x >> 6, i = threadIdx.x & 63;
    const float pos = (float)(m % S_);
    const float inv = 1.0f / powf(10000.0f, (float)i / 64.0f);
    const float ang = pos * inv;
    float sn, cs; sincosf(ang, &sn, &cs);
    float* q = z + (size_t)m * DIN + O_RQ + h * HD;
    float* k = z + (size_t)m * DIN + O_RK + h * HD;
    const float q1 = q[i], q2 = q[i + 64], k1 = k[i], k2 = k[i + 64];
    q[i] = q1 * cs - q2 * sn; q[i + 64] = q1 * sn + q2 * cs;
    const float sc = 0.08838834764831845f;
    k[i] = (k1 * cs - k2 * sn) * sc; k[i + 64] = (k1 * sn + k2 * cs) * sc;
}
__device__ __forceinline__ float log_gamma(int h) { return logf(1.0f - exp2f(-5.0f - (float)h)); }

__global__ __launch_bounds__(256) void k_ret_upd(const float* __restrict__ z, float* __restrict__ U) {
    extern __shared__ float sm[];
    float* Ks = sm; float* Vs = sm + 64 * 128;
    const int blk = blockIdx.x, n = blk % NCH, bh = blk / NCH, h = bh % RET_H, b = bh / RET_H;
    const float lg = log_gamma(h);
    for (int idx = threadIdx.x; idx < 64 * 128; idx += 256) {
        const int l = idx >> 7, c = idx & 127; const size_t row = (size_t)(b * S_ + n * CH + l) * DIN;
        Ks[idx] = z[row + O_RK + h * HD + c];
        Vs[idx] = z[row + O_RV + h * HD + c] * expf(lg * (63.0f - (float)l));
    }
    __syncthreads();
    const int e = threadIdx.x & 127, dg = threadIdx.x >> 7;
    float acc[64];
    for (int i = 0; i < 64; ++i) acc[i] = 0.f;
    for (int l = 0; l < 64; ++l) { const float v = Vs[l * 128 + e];
#pragma unroll
        for (int i = 0; i < 64; ++i) acc[i] += Ks[l * 128 + dg * 64 + i] * v; }
    float* Uo = U + (size_t)blk * 128 * 128;
    for (int i = 0; i < 64; ++i) Uo[(dg * 64 + i) * 128 + e] = acc[i];
}
__global__ void k_ret_scan(const float* __restrict__ U, float* __restrict__ Sst) {
    const int idx = blockIdx.x * blockDim.x + threadIdx.x;
    const int bh = idx >> 14, de = idx & 16383, h = bh % RET_H;
    const float dec = expf(log_gamma(h) * 64.0f);
    float s = 0.f;
    for (int n = 0; n < NCH; ++n) { const size_t o = ((size_t)(bh * NCH + n) << 14) + de; Sst[o] = s; s = dec * s + U[o]; }
}
__global__ __launch_bounds__(256) void k_ret_out(const float* __restrict__ z, const float* __restrict__ Sst, float* __restrict__ y) {
    extern __shared__ float sm[];
    float* sc = sm;
    float* ob = sm + 64 * 64;
    const int blk = blockIdx.x, n = blk % NCH, bh = blk / NCH, h = bh % RET_H, b = bh / RET_H;
    const float lg = log_gamma(h);
    const size_t row0 = (size_t)(b * S_ + n * CH);
    for (int idx = threadIdx.x; idx < 64 * 64; idx += 256) {
        const int c = idx >> 6, l = idx & 63;
        const float* q = z + (row0 + c) * DIN + O_RQ + h * HD; const float* k = z + (row0 + l) * DIN + O_RK + h * HD;
        float s = 0.f; for (int d = 0; d < HD; ++d) s += q[d] * k[d];
        sc[idx] = s * expf(lg * fabsf((float)(c - l)));
    }
    __syncthreads();
    const int e = threadIdx.x & 127, cg = threadIdx.x >> 7;
    const float* Sp = Sst + (size_t)blk * 128 * 128;
    for (int c = cg * 32; c < cg * 32 + 32; ++c) {
        float o = 0.f;
        for (int l = 0; l < 64; ++l) o += sc[c * 64 + l] * z[(row0 + l) * DIN + O_RV + h * HD + e];
        const float* q = z + (row0 + c) * DIN + O_RQ + h * HD;
        float cr = 0.f; for (int d = 0; d < HD; ++d) cr += q[d] * Sp[d * 128 + e];
        ob[c * 128 + e] = o + cr * expf(lg * ((float)c + 1.0f));
    }
    __syncthreads();
    const int w = threadIdx.x >> 6, lane = threadIdx.x & 63;
    for (int c = w; c < 64; c += 4) {
        const float a0 = ob[c * 128 + lane], a1 = ob[c * 128 + 64 + lane];
        float s = a0 + a1; for (int o = 32; o >= 1; o >>= 1) s += __shfl_xor(s, o);
        const float mu = s / 128.f; const float d0 = a0 - mu, d1 = a1 - mu;
        float v = d0 * d0 + d1 * d1; for (int o = 32; o >= 1; o >>= 1) v += __shfl_xor(v, o);
        const float rs = rsqrtf(v / 128.f + EPS);
        const float* g = z + (row0 + c) * DIN + O_RG + h * HD;
        float* yo = y + (row0 + c) * D_ + h * HD;
        yo[lane] = d0 * rs * silu_f(g[lane]); yo[lane + 64] = d1 * rs * silu_f(g[lane + 64]);
    }
}

__global__ void k_gla_prep(const float* __restrict__ z, const float* __restrict__ Wa, const float* __restrict__ ba, float* __restrict__ Bc) {
    const int col = threadIdx.x; const size_t row0 = (size_t)blockIdx.x * CH;
    float w[GRANK]; for (int r = 0; r < GRANK; ++r) w[r] = Wa[r * 256 + col];
    const float bb = ba[col]; float cum = 0.f;
    for (int c = 0; c < CH; ++c) {
        const float* ga = z + (row0 + c) * DIN + O_GA;
        float x = bb; for (int r = 0; r < GRANK; ++r) x += ga[r] * w[r];
        const float ls = fminf(x, 0.f) - log1pf(expf(-fabsf(x)));
        cum += ls / 16.0f;
        Bc[(row0 + c) * 256 + col] = cum;
    }
}
__global__ __launch_bounds__(256) void k_gla_upd(const float* __restrict__ z, const float* __restrict__ Bc, float* __restrict__ Ug, float* __restrict__ Gg) {
    extern __shared__ float sm[];
    float* Ks = sm; float* Vs = sm + 64 * 64;
    const int blk = blockIdx.x, n = blk % NCH, bh = blk / NCH, h = bh % GLA_H, b = bh / GLA_H;
    const size_t row0 = (size_t)(b * S_ + n * CH);
    for (int idx = threadIdx.x; idx < 64 * 64; idx += 256) {
        const int l = idx >> 6, d = idx & 63;
        const float bl = Bc[(row0 + 63) * 256 + h * 64 + d], bb = Bc[(row0 + l) * 256 + h * 64 + d];
        Ks[idx] = z[(row0 + l) * DIN + O_GK + h * GDK + d] * expf(bl - bb);
    }
    for (int idx = threadIdx.x; idx < 64 * 128; idx += 256) { const int l = idx >> 7, e = idx & 127; Vs[idx] = z[(row0 + l) * DIN + O_GV + h * GDV + e]; }
    __syncthreads();
    const int e = threadIdx.x & 127, dg = threadIdx.x >> 7;
    float acc[32]; for (int i = 0; i < 32; ++i) acc[i] = 0.f;
    for (int l = 0; l < 64; ++l) { const float v = Vs[l * 128 + e];
#pragma unroll
        for (int i = 0; i < 32; ++i) acc[i] += Ks[l * 64 + dg * 32 + i] * v; }
    float* Uo = Ug + (size_t)blk * 64 * 128;
    for (int i = 0; i < 32; ++i) Uo[(dg * 32 + i) * 128 + e] = acc[i];
    if (threadIdx.x < 64) Gg[(size_t)blk * 64 + threadIdx.x] = expf(Bc[(row0 + 63) * 256 + h * 64 + threadIdx.x]);
}
__global__ void k_gla_scan(const float* __restrict__ Ug, const float* __restrict__ Gg, float* __restrict__ Sg) {
    const int idx = blockIdx.x * blockDim.x + threadIdx.x;
    const int bh = idx >> 13, de = idx & 8191, d = de >> 7;
    float s = 0.f;
    for (int n = 0; n < NCH; ++n) { const size_t o = ((size_t)(bh * NCH + n) << 13) + de; Sg[o] = s; s = Gg[(size_t)(bh * NCH + n) * 64 + d] * s + Ug[o]; }
}
__global__ __launch_bounds__(256) void k_gla_out(const float* __restrict__ z, const float* __restrict__ Bc, const float* __restrict__ Sg, float* __restrict__ y) {
    extern __shared__ float sm[];
    float* qi = sm;
    float* ki = sm + 4096;
    float* am = sm + 8192;
    float* ob = sm + 12288;
    const int blk = blockIdx.x, n = blk % NCH, bh = blk / NCH, h = bh % GLA_H, b = bh / GLA_H;
    const size_t row0 = (size_t)(b * S_ + n * CH);
    for (int idx = threadIdx.x; idx < 4096; idx += 256) {
        const int c = idx >> 6, d = idx & 63; const float bb = Bc[(row0 + c) * 256 + h * 64 + d];
        qi[idx] = z[(row0 + c) * DIN + O_GQ + h * GDK + d] * 0.125f * expf(bb);
        ki[idx] = z[(row0 + c) * DIN + O_GK + h * GDK + d] * expf(-bb);
    }
    __syncthreads();
    for (int idx = threadIdx.x; idx < 4096; idx += 256) {
        const int c = idx >> 6, l = idx & 63; float s = 0.f;
        if (c >= l) for (int d = 0; d < 64; ++d) s += qi[c * 64 + d] * ki[l * 64 + d];
        am[idx] = s;
    }
    __syncthreads();
    const int e = threadIdx.x & 127, cg = threadIdx.x >> 7;
    const float* Sp = Sg + (size_t)blk * 64 * 128;
    for (int c = cg * 32; c < cg * 32 + 32; ++c) {
        float o = 0.f;
        for (int l = 0; l <= c; ++l) o += am[c * 64 + l] * z[(row0 + l) * DIN + O_GV + h * GDV + e];
        for (int d = 0; d < 64; ++d) o += qi[c * 64 + d] * Sp[d * 128 + e];
        ob[c * 128 + e] = o;
    }
    __syncthreads();
    const int w = threadIdx.x >> 6, lane = threadIdx.x & 63;
    for (int c = w; c < 64; c += 4) {
        const float a0 = ob[c * 128 + lane], a1 = ob[c * 128 + 64 + lane];
        float v = a0 * a0 + a1 * a1; for (int o = 32; o >= 1; o >>= 1) v += __shfl_xor(v, o);
        const float rs = rsqrtf(v / 128.f + EPS);
        const float* g = z + (row0 + c) * DIN + O_GG + h * GDV;
        float* yo = y + (row0 + c) * D_ + 768 + h * GDV;
        yo[lane] = a0 * rs * silu_f(g[lane]); yo[lane + 64] = a1 * rs * silu_f(g[lane + 64]);
    }
}

__global__ __launch_bounds__(256) void k_attn(const float* __restrict__ z, const float* __restrict__ relb, float* __restrict__ y) {
    extern __shared__ float sm[];
    float* qs = sm;
    float* ps = sm + 16 * 128;
    float* os = ps + 16 * 576;
    const int blk = blockIdx.x, qq = blk & 3, n = (blk >> 2) % NCH, bh = (blk >> 2) / NCH, h = bh % ATT_H, b = bh / ATT_H;
    const size_t row0 = (size_t)(b * S_ + n * CH + qq * 16);
    for (int idx = threadIdx.x; idx < 16 * 128; idx += 256) qs[idx] = z[(row0 + (idx >> 7)) * DIN + O_AQ + h * HD + (idx & 127)] * 0.08838834764831845f;
    __syncthreads();
    for (int idx = threadIdx.x; idx < 16 * 576; idx += 256) {
        const int c = idx / 576, j = idx % 576; const int kc = n - 8 + j / 64;
        float s = -1e30f;
        if (kc >= 0) {
            const float* k = z + (size_t)(b * S_ + kc * CH + (j & 63)) * DIN + O_AK + h * HD;
            float a = 0.f; for (int d = 0; d < HD; ++d) a += qs[c * 128 + d] * k[d];
            int rel = 512 + (qq * 16 + c) - j; rel = rel > 128 ? 128 : (rel < -128 ? -128 : rel);
            s = a + relb[h * 257 + rel + 128];
        }
        ps[idx] = s;
    }
    __syncthreads();
    { const int c = threadIdx.x >> 4, t = threadIdx.x & 15;
      float mx = -3e38f; for (int j = t; j < 576; j += 16) mx = fmaxf(mx, ps[c * 576 + j]);
      for (int o = 8; o >= 1; o >>= 1) mx = fmaxf(mx, __shfl_xor(mx, o));
      float sum = 0.f; for (int j = t; j < 576; j += 16) { const float p = expf(ps[c * 576 + j] - mx); ps[c * 576 + j] = p; sum += p; }
      for (int o = 8; o >= 1; o >>= 1) sum += __shfl_xor(sum, o);
      const float inv = 1.f / sum; for (int j = t; j < 576; j += 16) ps[c * 576 + j] *= inv; }
    __syncthreads();
    const int e = threadIdx.x & 127, cg = threadIdx.x >> 7;
    float acc[8]; for (int i = 0; i < 8; ++i) acc[i] = 0.f;
    for (int j = 0; j < 576; ++j) { const int kc = n - 8 + j / 64; if (kc < 0) continue;
        const float v = z[(size_t)(b * S_ + kc * CH + (j & 63)) * DIN + O_AV + h * HD + e];
        for (int i = 0; i < 8; ++i) acc[i] += ps[(cg * 8 + i) * 576 + j] * v; }
    for (int i = 0; i < 8; ++i) os[(cg * 8 + i) * 128 + e] = acc[i];
    __syncthreads();
    const int w = threadIdx.x >> 6, lane = threadIdx.x & 63;
    for (int c = w; c < 16; c += 4) {
        const float a0 = os[c * 128 + lane], a1 = os[c * 128 + 64 + lane];
        float v = a0 * a0 + a1 * a1; for (int o = 32; o >= 1; o >>= 1) v += __shfl_xor(v, o);
        const float rs = rsqrtf(v / 128.f + EPS);
        float* yo = y + (row0 + c) * D_ + 1280 + h * HD;
        yo[lane] = a0 * rs; yo[lane + 64] = a1 * rs;
    }
}

__global__ void k_scale_cols(float* __restrict__ y, const float* __restrict__ s) {
    float* yr = y + (size_t)blockIdx.x * D_;
    for (int i = 0; i < 8; ++i) yr[threadIdx.x + 256 * i] *= s[threadIdx.x + 256 * i];
}
__global__ void k_add(float* __restrict__ x, const float* __restrict__ a, size_t n) { size_t i = (size_t)blockIdx.x * blockDim.x + threadIdx.x; if (i < n) x[i] += a[i]; }
__global__ void k_ple_comb(float* __restrict__ x, const float* __restrict__ gl, const float* __restrict__ pr, size_t n) {
    size_t i = (size_t)blockIdx.x * blockDim.x + threadIdx.x; if (i < n) x[i] += pr[i] / (1.f + expf(-gl[i])); }

__global__ void k_route(const float* __restrict__ h, const float* __restrict__ wrg, const float* __restrict__ brg, const float* __restrict__ wre, const float* __restrict__ bre, int* __restrict__ route) {
    const int tok = blockIdx.x * 4 + (threadIdx.x >> 6), lane = threadIdx.x & 63;
    float acc[36]; for (int i = 0; i < 36; ++i) acc[i] = 0.f;
    const float* hr = h + (size_t)tok * D_;
    for (int k = lane; k < D_; k += 64) { const float hv = hr[k];
        for (int j = 0; j < 4; ++j) acc[j] += hv * wrg[k * 4 + j];
        for (int j = 0; j < 32; ++j) acc[4 + j] += hv * wre[k * 32 + j]; }
    for (int i = 0; i < 36; ++i) for (int o = 32; o >= 1; o >>= 1) acc[i] += __shfl_xor(acc[i], o);
    if (lane == 0) {
        float lg[4], mx = -3e38f; int g = 0;
#pragma unroll
        for (int j = 0; j < 4; ++j) { lg[j] = acc[j] + brg[j]; if (lg[j] > mx) { mx = lg[j]; g = j; } }
        float sum = 0.f;
#pragma unroll
        for (int j = 0; j < 4; ++j) sum += expf(lg[j] - mx);
        const float pg = 1.f / sum;
        float el[8], m2 = -3e38f;
#pragma unroll
        for (int e = 0; e < 8; ++e) { float v = 0.f;
#pragma unroll
            for (int gg = 0; gg < 4; ++gg) v = (gg == g) ? acc[4 + gg * 8 + e] : v;
            el[e] = v + bre[g * 8 + e]; m2 = fmaxf(m2, el[e]); }
        float pe[8], s2 = 0.f;
#pragma unroll
        for (int e = 0; e < 8; ++e) { pe[e] = expf(el[e] - m2); s2 += pe[e]; }
        int e1 = 0; float p1 = -1.f;
#pragma unroll
        for (int e = 0; e < 8; ++e) { pe[e] /= s2; if (pe[e] > p1) { p1 = pe[e]; e1 = e; } }
        int e2 = 0; float p2 = -1.f;
#pragma unroll
        for (int e = 0; e < 8; ++e) if (e != e1 && pe[e] > p2) { p2 = pe[e]; e2 = e; }
        const float ws = p1 + p2;
        int* r = route + (size_t)tok * 8;
        r[0] = g; r[1] = e1; r[2] = e2; r[3] = __float_as_int(pg * (p1 / ws)); r[4] = __float_as_int(pg * (p2 / ws));
    }
}
__global__ __launch_bounds__(256) void k_moe_hid(const float* __restrict__ h, const int* __restrict__ route, const float* __restrict__ wg, const float* __restrict__ wu, float* __restrict__ hid) {
    __shared__ float hs[D_];
    const int tok = blockIdx.x >> 1, slot = blockIdx.x & 1;
    const int* r = route + (size_t)tok * 8; const int ge = r[0] * NE + r[1 + slot]; const float cw = __int_as_float(r[3 + slot]);
    for (int i = threadIdx.x; i < D_; i += 256) hs[i] = h[(size_t)tok * D_ + i];
    __syncthreads();
    const float* g = wg + (size_t)ge * D_ * FF + threadIdx.x; const float* u = wu + (size_t)ge * D_ * FF + threadIdx.x;
    float a = 0.f, b = 0.f;
    for (int k = 0; k < D_; ++k) { a += hs[k] * g[(size_t)k * FF]; b += hs[k] * u[(size_t)k * FF]; }
    hid[(size_t)blockIdx.x * FF + threadIdx.x] = silu_f(a) * b * cw;
}
__global__ __launch_bounds__(256) void k_moe_down(float* __restrict__ x, const int* __restrict__ route, const float* __restrict__ wd, const float* __restrict__ hid) {
    __shared__ float hs[2 * FF];
    const int tok = blockIdx.x; const int* r = route + (size_t)tok * 8;
    for (int i = threadIdx.x; i < 2 * FF; i += 256) hs[i] = hid[(size_t)tok * 2 * FF + i];
    __syncthreads();
    float acc[8]; for (int j = 0; j < 8; ++j) acc[j] = 0.f;
    for (int slot = 0; slot < 2; ++slot) { const float* w = wd + (size_t)(r[0] * NE + r[1 + slot]) * FF * D_;
        for (int f = 0; f < FF; ++f) { const float hv = hs[slot * FF + f];
            for (int j = 0; j < 8; ++j) acc[j] += hv * w[(size_t)f * D_ + threadIdx.x + 256 * j]; } }
    for (int j = 0; j < 8; ++j) x[(size_t)tok * D_ + threadIdx.x + 256 * j] += acc[j];
}
}

extern "C" void kernel_launch(void* const* d_in, const int* in_sizes, int n_in, void* d_out, int out_size, void* d_ws, size_t ws_size, hipStream_t stream) {
    const float* x_in = (const float*)d_in[0]; const float* p = (const float*)d_in[1]; const float* g_mix = (const float*)d_in[2]; const float* w_in = (const float*)d_in[3];
    const float* gla_w = (const float*)d_in[4]; const float* gla_b = (const float*)d_in[5]; const float* relb = (const float*)d_in[6]; const float* mix_scale = (const float*)d_in[7];
    const float* w_out = (const float*)d_in[8]; const float* g_ffn = (const float*)d_in[9]; const float* w_rg = (const float*)d_in[10]; const float* b_rg = (const float*)d_in[11];
    const float* w_re = (const float*)d_in[12]; const float* b_re = (const float*)d_in[13]; const float* w_eg = (const float*)d_in[14]; const float* w_eu = (const float*)d_in[15];
    const float* w_ed = (const float*)d_in[16]; const float* g_ple = (const float*)d_in[17]; const float* w_pg = (const float*)d_in[18]; const float* w_pp = (const float*)d_in[19];
    const float* g_final = (const float*)d_in[20];
    float* x = (float*)d_out;
    char* ws = (char*)d_ws; size_t off = 0;
    auto carve = [&](size_t bytes) { char* q = ws + off; off += (bytes + 255) & ~(size_t)255; return q; };
    float* hbuf = (float*)carve((size_t)T_ * D_ * 4);
    float* z = (float*)carve((size_t)T_ * DIN * 4);
    float* y = (float*)carve((size_t)T_ * D_ * 4);
    float* Ur = (float*)carve((size_t)12 * NCH * 128 * 128 * 4);
    float* Sr = (float*)carve((size_t)12 * NCH * 128 * 128 * 4);
    float* Ug = (float*)carve((size_t)8 * NCH * 64 * 128 * 4);
    float* Sg = (float*)carve((size_t)8 * NCH * 64 * 128 * 4);
    float* Gg = (float*)carve((size_t)8 * NCH * 64 * 4);
    float* Bc = (float*)carve((size_t)T_ * 256 * 4);
    float* hid = (float*)carve((size_t)T_ * 2 * FF * 4);
    int* route = (int*)carve((size_t)T_ * 8 * 4);
    float* t1 = z;
    float* t2 = z + (size_t)T_ * D_;
    static bool attr = false;
    if (!attr) { hipFuncSetAttribute((const void*)k_ret_upd, hipFuncAttributeMaxDynamicSharedMemorySize, 65536);
        hipFuncSetAttribute((const void*)k_gla_out, hipFuncAttributeMaxDynamicSharedMemorySize, 81920); attr = true; }
    const size_t nx = (size_t)T_ * D_;
    hipMemcpyAsync(x, x_in, nx * 4, hipMemcpyDeviceToDevice, stream);
    for (int l = 0; l < DEPTH_; ++l) {
        k_rmsnorm<<<T_, 256, 0, stream>>>(x, g_mix + l * D_, hbuf);
        k_sgemm<<<dim3((DIN + 127) / 128, T_ / 128), 256, 0, stream>>>(hbuf, w_in + (size_t)l * D_ * DIN, z, T_, DIN, D_, D_, DIN, DIN);
        k_rotary<<<T_, 384, 0, stream>>>(z);
        k_ret_upd<<<12 * NCH, 256, 65536, stream>>>(z, Ur);
        k_ret_scan<<<12 * 16384 / 256, 256, 0, stream>>>(Ur, Sr);
        k_ret_out<<<12 * NCH, 256, (64 * 64 + 64 * 128) * 4, stream>>>(z, Sr, y);
        k_gla_prep<<<B_ * NCH, 256, 0, stream>>>(z, gla_w + (size_t)l * GRANK * 256, gla_b + l * 256, Bc);
        k_gla_upd<<<8 * NCH, 256, (64 * 64 + 64 * 128) * 4, stream>>>(z, Bc, Ug, Gg);
        k_gla_scan<<<8 * 8192 / 256, 256, 0, stream>>>(Ug, Gg, Sg);
        k_gla_out<<<8 * NCH, 256, (3 * 4096 + 64 * 128) * 4, stream>>>(z, Bc, Sg, y);
        k_attn<<<B_ * ATT_H * NCH * 4, 256, (16 * 128 + 16 * 576 + 16 * 128) * 4, stream>>>(z, relb + (size_t)l * ATT_H * 257, y);
        k_scale_cols<<<T_, 256, 0, stream>>>(y, mix_scale + l * D_);
        k_sgemm<<<dim3(D_ / 128, T_ / 128), 256, 0, stream>>>(y, w_out + (size_t)l * D_ * D_, t1, T_, D_, D_, D_, D_, D_);
        k_add<<<(unsigned)(nx / 256), 256, 0, stream>>>(x, t1, nx);
        k_rmsnorm<<<T_, 256, 0, stream>>>(x, g_ffn + l * D_, hbuf);
        k_route<<<T_ / 4, 256, 0, stream>>>(hbuf, w_rg + (size_t)l * D_ * 4, b_rg + l * 4, w_re + (size_t)l * D_ * 32, b_re + l * 32, route);
        k_moe_hid<<<T_ * 2, 256, 0, stream>>>(hbuf, route, w_eg + (size_t)l * 32 * D_ * FF, w_eu + (size_t)l * 32 * D_ * FF, hid);
        k_moe_down<<<T_, 256, 0, stream>>>(x, route, w_ed + (size_t)l * 32 * FF * D_, hid);
        k_rmsnorm<<<T_, 256, 0, stream>>>(x, g_ple + l * D_, hbuf);
        k_sgemm<<<dim3(D_ / 128, T_ / 128), 256, 0, stream>>>(hbuf, w_pg + (size_t)l * D_ * D_, t1, T_, D_, D_, D_, D_, D_);
        k_sgemm<<<dim3(D_ / 128, T_ / 128), 256, 0, stream>>>(p + (size_t)l * T_ * PLE, w_pp + (size_t)l * PLE * D_, t2, T_, D_, PLE, PLE, D_, D_);
        k_ple_comb<<<(unsigned)(nx / 256), 256, 0, stream>>>(x, t1, t2, nx);
    }
    k_rmsnorm<<<T_, 256, 0, stream>>>(x, g_final, hbuf);
    hipMemcpyAsync(x, hbuf, nx * 4, hipMemcpyDeviceToDevice, stream);
}
```

```cpp
#include <hip/hip_runtime.h>
#include <math.h>
#include <stdio.h>

#define LAS __attribute__((address_space(3)))
#define GAS __attribute__((address_space(1)))
typedef unsigned short bf16;
typedef short bf16x8 __attribute__((ext_vector_type(8)));
typedef float f32x4 __attribute__((ext_vector_type(4)));
typedef float f32x2 __attribute__((ext_vector_type(2)));
typedef unsigned u32x4 __attribute__((ext_vector_type(4)));
typedef unsigned u32x2 __attribute__((ext_vector_type(2)));

constexpr int B_ = 2, S_ = 8192, T_ = B_ * S_, D_ = 2048, DEPTH_ = 4, DIN = 6928, ZLD = 7168, CH = 64, NCH = S_ / CH;
constexpr int RET_H = 6, GLA_H = 4, ATT_H = 6, HD = 128, GDK = 64, GDV = 128, GRANK = 16;
constexpr int O_RQ = 0, O_RK = 768, O_RV = 1536, O_RG = 2304, O_GQ = 3072, O_GK = 3328, O_GV = 3584, O_GG = 4096, O_AQ = 4608, O_AK = 5376, O_AV = 6144, O_GA = 6912;
constexpr int NG = 4, NE = 8, FF = 256, PLE = 256;
constexpr float EPS = 1e-6f;
constexpr int NWAVES = 8, NTHR = 512;

constexpr size_t MiB = 1u << 20;
constexpr size_t WS_CTL = 0, CTL_BYTES = 2 * MiB;
constexpr int CW_BAR = 1024;
constexpr int CW_CNT = 8192;
constexpr size_t SS_OFF = 256 * 1024;
constexpr size_t WS_WIN = WS_CTL + CTL_BYTES;
constexpr size_t WS_WOUT = WS_WIN + (size_t)DEPTH_ * ZLD * D_ * 2;
constexpr size_t WS_WPG = WS_WOUT + (size_t)DEPTH_ * D_ * D_ * 2;
constexpr size_t WS_WPP = WS_WPG + (size_t)DEPTH_ * D_ * D_ * 2;
constexpr size_t WS_WGU = WS_WPP + (size_t)DEPTH_ * D_ * PLE * 2;
constexpr size_t WS_WD = WS_WGU + (size_t)DEPTH_ * 32 * 512 * D_ * 2;
constexpr size_t WS_WR = WS_WD + (size_t)DEPTH_ * 4 * D_ * D_ * 2;
constexpr size_t WS_ROT = WS_WR + (size_t)DEPTH_ * 48 * D_ * 4;
constexpr size_t WS_SSP = WS_ROT + (size_t)2 * S_ * 64 * 4;
constexpr size_t WS_PB = WS_SSP + (size_t)13 * 8 * T_ * 4;
constexpr size_t WS_XB0 = WS_PB + (size_t)DEPTH_ * T_ * PLE * 2;
constexpr size_t WS_XB1 = WS_XB0 + (size_t)T_ * D_ * 2;
constexpr size_t WS_Z = WS_XB1 + (size_t)T_ * D_ * 2;
constexpr size_t WS_Y = WS_Z + (size_t)T_ * ZLD * 2;
constexpr size_t WS_SCR = WS_Y + (size_t)T_ * D_ * 2;
constexpr size_t SC_UR = 0;
constexpr size_t SC_SR = SC_UR + (size_t)12 * NCH * 128 * 128 * 4;
constexpr size_t SC_UG = SC_SR + (size_t)12 * NCH * 128 * 128 * 4;
constexpr size_t SC_SG = SC_UG + (size_t)8 * NCH * 64 * 128 * 4;
constexpr size_t SC_GG = SC_SG + (size_t)8 * NCH * 64 * 128 * 4;
constexpr size_t SC_BC = SC_GG + (size_t)8 * NCH * 64 * 4;
constexpr size_t SC_END = SC_BC + (size_t)T_ * 256 * 4;
constexpr size_t SC_ENT = 0;
constexpr size_t SC_HIDB = SC_ENT + (size_t)112 * T_ * 16;
static_assert(SC_HIDB + (size_t)(T_ + 256) * 512 * 2 <= SC_UG, "MoE scratch must stay clear of PROJ");
constexpr size_t WS_END = WS_SCR + SC_END;
constexpr size_t WS_PROJ = WS_SCR + SC_UG;
static_assert(SC_GG - SC_UG == (size_t)T_ * D_ * 2 && WS_END <= 1377669792ull, "ws map");

__device__ __forceinline__ float bf2f(bf16 v) { return __uint_as_float(((unsigned)v) << 16); }
__device__ __forceinline__ unsigned f2bf(float f) { unsigned u = __float_as_uint(f); return (u + 0x7fffu + ((u >> 16) & 1u)) >> 16; }
__device__ __forceinline__ unsigned pk2(float lo, float hi) { return f2bf(lo) | (f2bf(hi) << 16); }
__device__ __forceinline__ unsigned cvt_pk_bf16(float lo, float hi) { unsigned r; asm volatile("v_cvt_pk_bf16_f32 %0, %1, %2" : "=v"(r) : "v"(lo), "v"(hi)); return r; }
__device__ __forceinline__ float silu_f(float x) { return x / (1.f + __expf(-x)); }
__device__ __forceinline__ float wave_sum(float v) {
#pragma unroll
    for (int o = 1; o < 64; o <<= 1) v += __shfl_xor(v, o);
    return v;
}
__device__ __forceinline__ int lane_opaque() { int l; asm volatile("v_mbcnt_lo_u32_b32 %0, -1, 0\n\tv_mbcnt_hi_u32_b32 %0, -1, %0" : "=v"(l)); return l; }
__device__ __forceinline__ float row_rs(const float* ssp, int row) {
    float s = 0.f;
#pragma unroll
    for (int p = 0; p < 8; ++p) s += ssp[(size_t)p * T_ + row];
    return rsqrtf(s * (1.0f / D_) + EPS);
}
__device__ __forceinline__ float sx16(float v) { return __int_as_float(__builtin_amdgcn_ds_swizzle(__float_as_int(v), 0x401F)); }
__device__ __forceinline__ float sx32(float v, int lane) { return __int_as_float(__builtin_amdgcn_ds_bpermute((lane ^ 32) << 2, __float_as_int(v))); }
#define LDS_WAIT() asm volatile("s_waitcnt lgkmcnt(0)" ::: "memory")
#define VM_WAIT() asm volatile("s_waitcnt vmcnt(0)" ::: "memory")

namespace pg8 {
constexpr int BM = 256, BK = 64, HALF = 128, HTB = HALF * BK * 2, STAGE_BYTES = 8 * HTB, NXCD = 8, WGM = 8;
__host__ __device__ __forceinline__ int lds_byte(int r, int c) { const int st = (r >> 4) * 2 + (c >> 5), rr = r & 15, cc = c & 31, ob = rr * 64 + cc * 2; return st * 1024 + (ob ^ (((ob >> 9) & 1) << 5)); }
__host__ __device__ __forceinline__ void stage_rc(int b, int& R, int& C) { const int st = b / 1024, sb = b % 1024, swz = sb ^ (((sb >> 9) & 1) << 5); R = (st >> 1) * 16 + swz / 64; C = (st & 1) * 32 + (swz % 64) / 2; }
__host__ __device__ __forceinline__ int perm32(int rho) { const int n = rho >> 4, i = rho & 15; return 8 * (i >> 2) + 4 * n + (i & 3); }

struct Unit { int pm, pn, x0, x1, x2; };

struct DenseOrder {
    int nM, nN, nwg, G, c; const char* A; const char* Bt; size_t astep, bstep;
    __device__ void init(const void* A_, const void* Bt_, int M, int N, int lda, int ldb, int G_, int c_) { A = (const char*)A_; Bt = (const char*)Bt_; nM = M / BM; nN = N / BM; nwg = nM * nN; G = G_; c = c_; astep = (size_t)BM * lda * 2; bstep = (size_t)BM * ldb * 2; }
    __device__ bool next(int i, Unit& u) const {
        const long L = (long)i * G + c; if (L >= nwg) return false;
        int wgid = (int)L; { const int q = nwg / NXCD, r = nwg % NXCD, xcd = wgid % NXCD, off = wgid / NXCD; wgid = (xcd < r ? xcd * (q + 1) : r * (q + 1) + (xcd - r) * q) + off; }
        const int nig = WGM * nN, gid = wgid / nig, fm = gid * WGM, gsz = (nM - fm) < WGM ? (nM - fm) : WGM;
        u.pm = fm + ((wgid % nig) % gsz); u.pn = (wgid % nig) / gsz; u.x0 = 0; u.x1 = 0; u.x2 = 0; return true;
    }
    __device__ __forceinline__ const char* a_ptr(const Unit& u) const { return A + (size_t)u.pm * astep; }
    __device__ __forceinline__ const char* b_ptr(const Unit& u, int t) const { return Bt + (size_t)u.pn * bstep + (size_t)t * (BK * 2); }
    __device__ __forceinline__ int a_row(const Unit&, int) const { return 0; }
    __device__ __forceinline__ void a_ready(const Unit&) const {}
    __device__ __forceinline__ void done(const Unit&) const {}
};

template <class Epi, class Sched, bool GATHER, bool ALIGN_EPI>
__device__ __forceinline__ void gemm_phase(LAS unsigned char* lds, const int wave_s, const int K, const int lda, const int ldb, const Sched& S, const Epi& E) {
    const int lane = lane_opaque();
    int wv_ = wave_s; asm volatile("" : "+s"(wv_));
    const int wid = __builtin_amdgcn_readfirstlane(wv_), tid = wid * 64 + lane, wr = wid >> 2, wc = wid & 3, fr = lane & 15, fq = lane >> 4;
    const int nt = K / BK;
    unsigned voffA[2], voffB[2]; int Rr[2], Cc[2];
#pragma unroll
    for (int i = 0; i < 2; ++i) { int R, C; stage_rc(tid * 16 + i * 8192, R, C); const int Rb = (R & ~31) + perm32(R & 31);
        Rr[i] = R; Cc[i] = C; voffA[i] = (unsigned)(R * lda + C) * 2u; voffB[i] = (unsigned)(Rb * ldb + C) * 2u; }
    const size_t kstep = (size_t)(BK * 2);
    const size_t hstepA = (size_t)HALF * lda * 2, hstepB = (size_t)HALF * ldb * 2;
    const unsigned ldsw = (unsigned)wid * 1024u;
    const int aoff = lds_byte(wr * 64 + fr, fq * 8), boff = lds_byte(wc * 32 + fr, fq * 8);
#define PG8_SA(b, h) (((b) * 2 + (h)) * HTB)
#define PG8_SB(b, h) ((4 + (b) * 2 + (h)) * HTB)
#define PG8_STAGE(bufoff, gbase, voff) do { _Pragma("unroll") for (int _i = 0; _i < 2; ++_i) \
        __builtin_amdgcn_global_load_lds((const unsigned*)((const char*)(gbase) + (voff)[_i]), (LAS unsigned*)(lds + (bufoff) + ldsw + _i * 8192), 16, 0, 0); } while (0)
#define PG8_STAGE_A(bufoff, gbase, h, vo) do { if constexpr (GATHER) { PG8_STAGE(bufoff, gbase, (vo)[h]); } else { PG8_STAGE(bufoff, (gbase) + (h) * hstepA, voffA); } } while (0)
#define PG8_STAGE_B(bufoff, gbase, h) PG8_STAGE(bufoff, (gbase) + (h) * hstepB, voffB)
#define PG8_LDA(dst, b, h) do { _Pragma("unroll") for (int m = 0; m < 4; ++m) _Pragma("unroll") for (int k = 0; k < 2; ++k) dst[m][k] = *(const LAS bf16x8*)(lds + PG8_SA(b, h) + aoff + m * 2048 + k * 1024); } while (0)
#define PG8_LDB(dst, b, h) do { _Pragma("unroll") for (int n = 0; n < 2; ++n) _Pragma("unroll") for (int k = 0; k < 2; ++k) dst[n][k] = *(const LAS bf16x8*)(lds + PG8_SB(b, h) + boff + n * 2048 + k * 1024); } while (0)
#define PG8_MMA(ai, bj, At, Bt) do { __builtin_amdgcn_s_setprio(1); _Pragma("unroll") for (int m = 0; m < 4; ++m) _Pragma("unroll") for (int n = 0; n < 2; ++n) _Pragma("unroll") for (int k = 0; k < 2; ++k) \
        acc[ai][bj][m][n] = __builtin_amdgcn_mfma_f32_16x16x32_bf16(Bt[n][k], At[m][k], acc[ai][bj][m][n], 0, 0, 0); __builtin_amdgcn_s_setprio(0); } while (0)
#define PG8_WAIT_V(n) asm volatile("s_waitcnt vmcnt(" #n ")" ::: "memory")
#define PG8_WAIT_L(n) asm volatile("s_waitcnt lgkmcnt(" #n ")" ::: "memory")
#define PG8_BAR __builtin_amdgcn_s_barrier()
#define PG8_SCHED __builtin_amdgcn_sched_barrier(0)
    Unit cur, nxt; int ui = 0;
    if (!S.next(0, cur)) return;
    f32x4 acc[2][2][4][2];
#pragma unroll
    for (int a = 0; a < 2; ++a)
#pragma unroll
        for (int b = 0; b < 2; ++b)
#pragma unroll
            for (int m = 0; m < 4; ++m)
#pragma unroll
                for (int n = 0; n < 2; ++n) acc[a][b][m][n] = (f32x4){0.f, 0.f, 0.f, 0.f};
    bf16x8 At[4][2], B0[2][2], B1[2][2];
    unsigned voC[2][2] = {{0u, 0u}, {0u, 0u}}, voN[2][2] = {{0u, 0u}, {0u, 0u}};
    const char* cA = S.a_ptr(cur);
    if constexpr (GATHER) {
#pragma unroll
        for (int h = 0; h < 2; ++h)
#pragma unroll
            for (int i = 0; i < 2; ++i) voC[h][i] = (unsigned)(S.a_row(cur, h * HALF + Rr[i]) * lda + Cc[i]) * 2u;
    }
    S.a_ready(cur);
    {   const char* b0p = S.b_ptr(cur, 0); const char* b1p = S.b_ptr(cur, 1);
        PG8_STAGE_B(PG8_SB(0, 0), b0p, 0); PG8_STAGE_B(PG8_SB(0, 1), b0p, 1); PG8_STAGE_A(PG8_SA(0, 0), cA, 0, voC); PG8_STAGE_A(PG8_SA(0, 1), cA, 1, voC);
        if (wr == 1) PG8_BAR;
        PG8_WAIT_V(2); PG8_BAR;
        PG8_STAGE_B(PG8_SB(1, 0), b1p, 0); PG8_STAGE_A(PG8_SA(1, 0), cA + kstep, 0, voC); PG8_STAGE_B(PG8_SB(1, 1), b1p, 1);
        PG8_WAIT_V(6); PG8_BAR; }
    for (;;) {
        const bool has_next = S.next(ui + 1, nxt);
        const char* nA = has_next ? S.a_ptr(nxt) : cA;
        for (int t = 0; t < nt; t += 2) {
            const bool last = (t == nt - 2);
            const char* a1 = cA + (size_t)(t + 1) * kstep;
            const char* a2 = last ? nA : cA + (size_t)(t + 2) * kstep; const char* a3 = a2 + kstep;
            const char* b2 = last ? (has_next ? S.b_ptr(nxt, 0) : S.b_ptr(cur, 0)) : S.b_ptr(cur, t + 2);
            const char* b3 = last ? (has_next ? S.b_ptr(nxt, 1) : S.b_ptr(cur, 1)) : S.b_ptr(cur, t + 3);
            unsigned vo2[2][2];
            if (last && has_next) { S.a_ready(nxt);
                if constexpr (GATHER) {
#pragma unroll
                    for (int h = 0; h < 2; ++h)
#pragma unroll
                        for (int i = 0; i < 2; ++i) voN[h][i] = (unsigned)(S.a_row(nxt, h * HALF + Rr[i]) * lda + Cc[i]) * 2u;
                } }
#pragma unroll
            for (int h = 0; h < 2; ++h)
#pragma unroll
                for (int i = 0; i < 2; ++i) vo2[h][i] = (last && has_next) ? voN[h][i] : voC[h][i];
            PG8_LDB(B0, 0, 0); PG8_LDB(B1, 0, 1); PG8_SCHED; PG8_LDA(At, 0, 0); PG8_STAGE_A(PG8_SA(1, 1), a1, 1, voC);
            PG8_WAIT_V(8); PG8_WAIT_L(0); PG8_BAR; PG8_MMA(0, 0, At, B0); PG8_MMA(0, 1, At, B1); PG8_BAR; PG8_SCHED;
            PG8_LDA(At, 0, 1); PG8_STAGE_B(PG8_SB(0, 0), b2, 0); PG8_STAGE_B(PG8_SB(0, 1), b2, 1); PG8_STAGE_A(PG8_SA(0, 0), a2, 0, vo2);
            PG8_WAIT_V(8); PG8_WAIT_L(0); PG8_BAR; PG8_MMA(1, 0, At, B0); PG8_MMA(1, 1, At, B1); PG8_BAR; PG8_SCHED;
            PG8_LDB(B0, 1, 0); PG8_LDB(B1, 1, 1); PG8_SCHED; PG8_LDA(At, 1, 0); PG8_STAGE_A(PG8_SA(0, 1), a2, 1, vo2);
            PG8_WAIT_V(8); PG8_WAIT_L(0); PG8_BAR; PG8_MMA(0, 0, At, B0); PG8_MMA(0, 1, At, B1); PG8_BAR; PG8_SCHED;
            PG8_LDA(At, 1, 1); PG8_STAGE_B(PG8_SB(1, 0), b3, 0); PG8_STAGE_B(PG8_SB(1, 1), b3, 1); PG8_STAGE_A(PG8_SA(1, 0), a3, 0, vo2);
            PG8_WAIT_V(8); PG8_WAIT_L(0); PG8_BAR; PG8_MMA(1, 0, At, B0); PG8_MMA(1, 1, At, B1); PG8_BAR; PG8_SCHED;
        }
        if constexpr (ALIGN_EPI) { if (wr == 0) PG8_BAR; }
        { const int le = lane_opaque(); E(acc, cur, wr, wc, le & 15, le >> 4); } S.done(cur);
        if (!has_next) break;
#pragma unroll
        for (int a = 0; a < 2; ++a)
#pragma unroll
            for (int b = 0; b < 2; ++b)
#pragma unroll
                for (int m = 0; m < 4; ++m)
#pragma unroll
                    for (int n = 0; n < 2; ++n) acc[a][b][m][n] = (f32x4){0.f, 0.f, 0.f, 0.f};
        cur = nxt; cA = nA; ++ui;
        if constexpr (GATHER) {
#pragma unroll
            for (int h = 0; h < 2; ++h)
#pragma unroll
                for (int i = 0; i < 2; ++i) voC[h][i] = voN[h][i];
        }
        if constexpr (ALIGN_EPI) { if (wr == 1) PG8_BAR; }
    }
    PG8_WAIT_V(0);
    if constexpr (!ALIGN_EPI) { if (wr == 0) PG8_BAR; }
    PG8_BAR;
#undef PG8_SA
#undef PG8_SB
#undef PG8_STAGE
#undef PG8_STAGE_A
#undef PG8_STAGE_B
#undef PG8_LDA
#undef PG8_LDB
#undef PG8_MMA
#undef PG8_WAIT_V
#undef PG8_WAIT_L
#undef PG8_BAR
#undef PG8_SCHED
}

struct EpiZ {
    bf16* O; const float* ss;
    __device__ __forceinline__ void operator()(const f32x4 (&acc)[2][2][4][2], const Unit& u, int wr, int wc, int fr, int fq) const {
        const int row0 = u.pm * BM + wr * 64 + fr, col0 = u.pn * BM + wc * 32 + 8 * fq;
#pragma unroll
        for (int ai = 0; ai < 2; ++ai)
#pragma unroll
            for (int m = 0; m < 4; ++m) { const int row = row0 + ai * HALF + m * 16; const float rs = row_rs(ss, row);
                bf16* rowp = O + (size_t)row * ZLD + col0;
#pragma unroll
                for (int bj = 0; bj < 2; ++bj) { const f32x4 v0 = acc[ai][bj][m][0] * rs, v1 = acc[ai][bj][m][1] * rs;
                    u32x4 w; w.x = cvt_pk_bf16(v0[0], v0[1]); w.y = cvt_pk_bf16(v0[2], v0[3]); w.z = cvt_pk_bf16(v1[0], v1[1]); w.w = cvt_pk_bf16(v1[2], v1[3]);
                    *(u32x4*)(rowp + bj * HALF) = w; } }
    }
};
struct EpiB {
    bf16* O; int ldc;
    __device__ __forceinline__ void operator()(const f32x4 (&acc)[2][2][4][2], const Unit& u, int wr, int wc, int fr, int fq) const {
        const int row0 = u.pm * BM + wr * 64 + fr, col0 = u.pn * BM + wc * 32 + 8 * fq;
#pragma unroll
        for (int ai = 0; ai < 2; ++ai)
#pragma unroll
            for (int m = 0; m < 4; ++m) { bf16* rowp = O + (size_t)(row0 + ai * HALF + m * 16) * ldc + col0;
#pragma unroll
                for (int bj = 0; bj < 2; ++bj) { const f32x4 v0 = acc[ai][bj][m][0], v1 = acc[ai][bj][m][1];
                    u32x4 w; w.x = cvt_pk_bf16(v0[0], v0[1]); w.y = cvt_pk_bf16(v0[2], v0[3]); w.z = cvt_pk_bf16(v1[0], v1[1]); w.w = cvt_pk_bf16(v1[2], v1[3]);
                    *(u32x4*)(rowp + bj * HALF) = w; } }
    }
};
__device__ __forceinline__ void ss_finish(LAS float* red, float* ssn, const Unit& u, int wr, int wc, int fr) {
    asm volatile("s_waitcnt lgkmcnt(0)" ::: "memory"); __builtin_amdgcn_s_barrier(); asm volatile("" ::: "memory");
    const int t = (wr * 4 + wc) * 64 + lane_opaque();
    if (t < 256) { const float v = ((red[t] + red[256 + t]) + red[512 + t]) + red[768 + t]; ssn[(size_t)u.pn * T_ + u.pm * BM + t] = v; }
    (void)fr;
}
struct EpiRes {
    float* X; bf16* XB; float* ssn; LAS float* red;
    __device__ __forceinline__ void operator()(const f32x4 (&acc)[2][2][4][2], const Unit& u, int wr, int wc, int fr, int fq) const {
        const int row0 = u.pm * BM + wr * 64 + fr, col0 = u.pn * BM + wc * 32 + 8 * fq;
#pragma unroll
        for (int ai = 0; ai < 2; ++ai)
#pragma unroll
            for (int m = 0; m < 4; ++m) { const int row = row0 + ai * HALF + m * 16; float* xr = X + (size_t)row * D_ + col0; bf16* br = XB + (size_t)row * D_ + col0; float s = 0.f;
#pragma unroll
                for (int bj = 0; bj < 2; ++bj) { const f32x4 v0 = acc[ai][bj][m][0] + *(const f32x4*)(xr + bj * HALF), v1 = acc[ai][bj][m][1] + *(const f32x4*)(xr + bj * HALF + 4);
                    *(f32x4*)(xr + bj * HALF) = v0; *(f32x4*)(xr + bj * HALF + 4) = v1;
                    s += (v0[0] * v0[0] + v0[1] * v0[1]) + (v0[2] * v0[2] + v0[3] * v0[3]) + (v1[0] * v1[0] + v1[1] * v1[1]) + (v1[2] * v1[2] + v1[3] * v1[3]);
                    u32x4 w; w.x = cvt_pk_bf16(v0[0], v0[1]); w.y = cvt_pk_bf16(v0[2], v0[3]); w.z = cvt_pk_bf16(v1[0], v1[1]); w.w = cvt_pk_bf16(v1[2], v1[3]);
                    *(u32x4*)(br + bj * HALF) = w; }
                s += sx16(s); s += sx32(s, fq * 16 + fr);
                if (fq == 0) red[wc * 256 + ai * HALF + wr * 64 + m * 16 + fr] = s;
                asm volatile("" ::: "memory"); }
        ss_finish(red, ssn, u, wr, wc, fr);
    }
};
struct EpiPle {
    float* X; bf16* XB; const bf16* PR; const float* ss; float* ssn; LAS float* red;
    __device__ __forceinline__ void operator()(const f32x4 (&acc)[2][2][4][2], const Unit& u, int wr, int wc, int fr, int fq) const {
        const int row0 = u.pm * BM + wr * 64 + fr, col0 = u.pn * BM + wc * 32 + 8 * fq;
#pragma unroll
        for (int ai = 0; ai < 2; ++ai)
#pragma unroll
            for (int m = 0; m < 4; ++m) { const int row = row0 + ai * HALF + m * 16; float* xr = X + (size_t)row * D_ + col0; bf16* br = XB + (size_t)row * D_ + col0; const bf16* pr = PR + (size_t)row * D_ + col0;
                const float rs = row_rs(ss, row); float s = 0.f;
#pragma unroll
                for (int bj = 0; bj < 2; ++bj) { const u32x4 pw = *(const u32x4*)(pr + bj * HALF);
                    const f32x4 p0 = {__uint_as_float(pw.x << 16), __uint_as_float(pw.x & 0xffff0000u), __uint_as_float(pw.y << 16), __uint_as_float(pw.y & 0xffff0000u)};
                    const f32x4 p1 = {__uint_as_float(pw.z << 16), __uint_as_float(pw.z & 0xffff0000u), __uint_as_float(pw.w << 16), __uint_as_float(pw.w & 0xffff0000u)};
                    f32x4 v0 = *(const f32x4*)(xr + bj * HALF), v1 = *(const f32x4*)(xr + bj * HALF + 4);
#pragma unroll
                    for (int j = 0; j < 4; ++j) { v0[j] += p0[j] / (1.f + __expf(-rs * acc[ai][bj][m][0][j])); v1[j] += p1[j] / (1.f + __expf(-rs * acc[ai][bj][m][1][j])); }
                    *(f32x4*)(xr + bj * HALF) = v0; *(f32x4*)(xr + bj * HALF + 4) = v1;
                    s += (v0[0] * v0[0] + v0[1] * v0[1]) + (v0[2] * v0[2] + v0[3] * v0[3]) + (v1[0] * v1[0] + v1[1] * v1[1]) + (v1[2] * v1[2] + v1[3] * v1[3]);
                    u32x4 w; w.x = cvt_pk_bf16(v0[0], v0[1]); w.y = cvt_pk_bf16(v0[2], v0[3]); w.z = cvt_pk_bf16(v1[0], v1[1]); w.w = cvt_pk_bf16(v1[2], v1[3]);
                    *(u32x4*)(br + bj * HALF) = w; }
                s += sx16(s); s += sx32(s, fq * 16 + fr);
                if (fq == 0) red[wc * 256 + ai * HALF + wr * 64 + m * 16 + fr] = s;
                asm volatile("" ::: "memory"); }
        ss_finish(red, ssn, u, wr, wc, fr);
    }
};

constexpr int MT_TILE = 8, MT_R0 = 200, MT_POS = 392, MT_CNT = 600, MT_MAXT = 190;
__device__ __forceinline__ void moe_build_table(LAS int* tb, const unsigned* cnt, int tidx) {
    if (tidx < 112) tb[MT_CNT + tidx] = (int)__hip_atomic_load(cnt + tidx, __ATOMIC_RELAXED, __HIP_MEMORY_SCOPE_AGENT);
    __syncthreads();
    if (tidx == 0) { int nt = 0, pos = 0;
        for (int b = 0; b < 112; ++b) { const int n = tb[MT_CNT + b]; const int g = b / 28; int p = b % 28, a = 0; while (p >= 7 - a) { p -= 7 - a; ++a; } const int eb = a + 1 + p;
            for (int r0 = 0; r0 < n && nt < MT_MAXT; r0 += 256) { const int nv = (n - r0) < 256 ? (n - r0) : 256;
                tb[MT_TILE + nt] = b | ((g * 8 + a) << 8) | ((g * 8 + eb) << 16); tb[MT_R0 + nt] = r0 | (nv << 16); tb[MT_POS + nt] = pos + r0; ++nt; }
            pos += n; }
        tb[0] = nt; }
    __syncthreads();
}
struct MoeOrder1 {
    LAS int* tb; const char* XB; const char* Wgu; const u32x4* ent; int G, c;
    __device__ bool next(int i, Unit& u) const { const int n = i * G + c; const int NT = __builtin_amdgcn_readfirstlane(tb[0]); if (n >= NT * 4) return false; const int t = n >> 2;
        u.pm = t; u.pn = n & 3; u.x0 = __builtin_amdgcn_readfirstlane(tb[MT_TILE + t]); u.x1 = __builtin_amdgcn_readfirstlane(tb[MT_R0 + t]); u.x2 = __builtin_amdgcn_readfirstlane(tb[MT_POS + t]); return true; }
    __device__ __forceinline__ const char* a_ptr(const Unit&) const { return XB; }
    __device__ __forceinline__ const char* b_ptr(const Unit& u, int t) const { const int ge = (u.pn < 2) ? ((u.x0 >> 8) & 255) : ((u.x0 >> 16) & 255);
        return Wgu + ((size_t)ge * 512 + (size_t)(u.pn & 1) * 256) * (D_ * 2) + (size_t)t * (BK * 2); }
    __device__ __forceinline__ int a_row(const Unit& u, int r) const { const int nv = u.x1 >> 16; const int r0 = u.x1 & 0xffff;
        return (int)ent[(size_t)(u.x0 & 255) * T_ + r0 + (r < nv ? r : 0)].x; }
    __device__ __forceinline__ void a_ready(const Unit&) const {}
    __device__ __forceinline__ void done(const Unit&) const {}
};
struct MoeOrder2 {
    LAS int* tb; const char* HID; const char* Wd; int G, c;
    __device__ bool next(int i, Unit& u) const { const int n = i * G + c; const int NT = __builtin_amdgcn_readfirstlane(tb[0]); if (n >= NT * 8) return false; const int t = n >> 3;
        u.pm = t; u.pn = n & 7; u.x0 = __builtin_amdgcn_readfirstlane(tb[MT_TILE + t]); u.x1 = __builtin_amdgcn_readfirstlane(tb[MT_R0 + t]); u.x2 = __builtin_amdgcn_readfirstlane(tb[MT_POS + t]); return true; }
    __device__ __forceinline__ const char* a_ptr(const Unit& u) const { return HID + (size_t)u.x2 * (512 * 2); }
    __device__ __forceinline__ const char* b_ptr(const Unit& u, int t) const { const int ge = (t < 4) ? ((u.x0 >> 8) & 255) : ((u.x0 >> 16) & 255);
        return Wd + (size_t)(ge >> 3) * ((size_t)D_ * D_ * 2) + (size_t)u.pn * 256 * (D_ * 2) + (size_t)((ge & 7) * 256 + (t & 3) * BK) * 2; }
    __device__ __forceinline__ int a_row(const Unit&, int) const { return 0; }
    __device__ __forceinline__ void a_ready(const Unit&) const {}
    __device__ __forceinline__ void done(const Unit&) const {}
};
struct EpiHid {
    bf16* HID; const u32x4* ent;
    __device__ __forceinline__ void operator()(const f32x4 (&acc)[2][2][4][2], const Unit& u, int wr, int wc, int fr, int fq) const {
        const int nv = u.x1 >> 16, r0 = u.x1 & 0xffff; const u32x4* eb = ent + (size_t)(u.x0 & 255) * T_ + r0;
        const int colo = (u.pn >> 1) * 256 + (u.pn & 1) * 128 + wc * 32 + 8 * fq;
#pragma unroll
        for (int ai = 0; ai < 2; ++ai)
#pragma unroll
            for (int m = 0; m < 4; ++m) { const int r = ai * HALF + wr * 64 + m * 16 + fr;
                if (r < nv) { const u32x4 e = eb[r]; const float rs = __uint_as_float(e.w), cw = __uint_as_float(u.pn < 2 ? e.y : e.z);
                    float h[8];
#pragma unroll
                    for (int n = 0; n < 2; ++n)
#pragma unroll
                        for (int j = 0; j < 4; ++j) { const float a = rs * acc[ai][0][m][n][j], up = rs * acc[ai][1][m][n][j]; h[n * 4 + j] = a / (1.f + __expf(-a)) * up * cw; }
                    u32x4 w; w.x = cvt_pk_bf16(h[0], h[1]); w.y = cvt_pk_bf16(h[2], h[3]); w.z = cvt_pk_bf16(h[4], h[5]); w.w = cvt_pk_bf16(h[6], h[7]);
                    *(u32x4*)(HID + (size_t)(u.x2 + r) * 512 + colo) = w; } }
    }
};
struct EpiMoe2 {
    float* X; bf16* XB; float* ssn; const u32x4* ent; LAS float* red;
    __device__ __forceinline__ void operator()(const f32x4 (&acc)[2][2][4][2], const Unit& u, int wr, int wc, int fr, int fq) const {
        const int nv = u.x1 >> 16, r0 = u.x1 & 0xffff; const u32x4* eb = ent + (size_t)(u.x0 & 255) * T_ + r0;
        const int col0 = u.pn * BM + wc * 32 + 8 * fq;
#pragma unroll
        for (int ai = 0; ai < 2; ++ai)
#pragma unroll
            for (int m = 0; m < 4; ++m) { const int r = ai * HALF + wr * 64 + m * 16 + fr; float s = 0.f;
                if (r < nv) { const int tok = (int)eb[r].x; float* xr = X + (size_t)tok * D_ + col0; bf16* br = XB + (size_t)tok * D_ + col0;
#pragma unroll
                    for (int bj = 0; bj < 2; ++bj) { const f32x4 v0 = acc[ai][bj][m][0] + *(const f32x4*)(xr + bj * HALF), v1 = acc[ai][bj][m][1] + *(const f32x4*)(xr + bj * HALF + 4);
                        *(f32x4*)(xr + bj * HALF) = v0; *(f32x4*)(xr + bj * HALF + 4) = v1;
                        s += (v0[0] * v0[0] + v0[1] * v0[1]) + (v0[2] * v0[2] + v0[3] * v0[3]) + (v1[0] * v1[0] + v1[1] * v1[1]) + (v1[2] * v1[2] + v1[3] * v1[3]);
                        u32x4 w; w.x = cvt_pk_bf16(v0[0], v0[1]); w.y = cvt_pk_bf16(v0[2], v0[3]); w.z = cvt_pk_bf16(v1[0], v1[1]); w.w = cvt_pk_bf16(v1[2], v1[3]);
                        *(u32x4*)(br + bj * HALF) = w; } }
                s += sx16(s); s += sx32(s, fq * 16 + fr);
                if (fq == 0) red[wc * 256 + r] = s;
                asm volatile("" ::: "memory"); }
        asm volatile("s_waitcnt lgkmcnt(0)" ::: "memory"); __builtin_amdgcn_s_barrier(); asm volatile("" ::: "memory");
        const int t = (wr * 4 + wc) * 64 + lane_opaque();
        if (t < nv) { const float v = ((red[t] + red[256 + t]) + red[512 + t]) + red[768 + t]; ssn[(size_t)u.pn * T_ + (int)eb[t].x] = v; }
    }
};
}


namespace mx {
typedef short s16x4 __attribute__((ext_vector_type(4)));
typedef short v4i16_t __attribute__((ext_vector_type(4)));
#define MFMA16(a, b, c) __builtin_amdgcn_mfma_f32_16x16x32_bf16((a), (b), (c), 0, 0, 0)
__device__ __forceinline__ bf16x8 frag_row(const LAS unsigned char* T, int P, int row0, int col0, int lane) { return *(const LAS bf16x8*)(T + (row0 + (lane & 15)) * P + (col0 + 8 * (lane >> 4)) * 2); }
__device__ __forceinline__ s16x4 ld_tr(const LAS unsigned char* p) { return __builtin_bit_cast(s16x4, __builtin_amdgcn_ds_read_tr16_b64_v4i16((LAS v4i16_t*)p)); }
__device__ __forceinline__ bf16x8 frag_tr(const LAS unsigned char* T, int P, int rowA, int rowB, int col0, int lane) {
    const int q = (lane & 15) >> 2, p = lane & 3;
    const s16x4 a = ld_tr(T + (rowA + q) * P + (col0 + 4 * p) * 2), b = ld_tr(T + (rowB + q) * P + (col0 + 4 * p) * 2);
    return (bf16x8){a[0], a[1], a[2], a[3], b[0], b[1], b[2], b[3]};
}
__device__ __forceinline__ bf16x8 pack8(const f32x4& a, const f32x4& b) { u32x4 w; w.x = cvt_pk_bf16(a[0], a[1]); w.y = cvt_pk_bf16(a[2], a[3]); w.z = cvt_pk_bf16(b[0], b[1]); w.w = cvt_pk_bf16(b[2], b[3]); return __builtin_bit_cast(bf16x8, w); }
constexpr int P128 = 272, P64 = 144;
constexpr int T64x128 = 64 * P128;

__device__ __forceinline__ void attn_items(LAS unsigned char* lds, const bf16* __restrict__ Z, const float* __restrict__ relb, bf16* __restrict__ Y, int G, int bx, int wave, int lane) {
    LAS unsigned char* Kb = lds; LAS unsigned char* Vb = lds + 2 * T64x128; LAS float* bs = (LAS float*)(lds + 4 * T64x128);
    const int i = lane & 15, g = lane >> 4, tid = wave * 64 + lane, grp = wave >> 2;
    for (int item = bx; item < B_ * ATT_H * (NCH / 2); item += G) {
        const int np = item & 63, bh = item >> 6, h = bh % ATT_H, b = bh / ATT_H, nA = 2 * np;
        const size_t tok0 = (size_t)b * S_ + (size_t)(nA + grp) * CH + 16 * (wave & 3);
        bf16x8 qf[4];
#pragma unroll
        for (int s = 0; s < 4; ++s) qf[s] = *(const bf16x8*)(Z + (tok0 + i) * ZLD + O_AQ + h * HD + 32 * s + 8 * g);
        for (int t = tid; t < 257; t += NTHR) bs[t] = relb[h * 257 + t];
        const int j0 = (nA < 8) ? (8 - nA) : 0;
        u32x4 kr[2], vr[2];
#define ATT_GLOAD(j) do { const size_t rb_ = (size_t)b * S_ + (size_t)(nA - 8 + (j)) * CH; _Pragma("unroll") for (int u_ = 0; u_ < 2; ++u_) { const int c_ = tid + NTHR * u_; \
            const bf16* zp_ = Z + (rb_ + (c_ >> 4)) * ZLD + h * HD + (c_ & 15) * 8; kr[u_] = *(const u32x4*)(zp_ + O_AK); vr[u_] = *(const u32x4*)(zp_ + O_AV); } } while (0)
#define ATT_LSTORE(buf) do { _Pragma("unroll") for (int u_ = 0; u_ < 2; ++u_) { const int c_ = tid + NTHR * u_; const int o_ = (buf) * T64x128 + (c_ >> 4) * P128 + (c_ & 15) * 16; \
            *(LAS u32x4*)(Kb + o_) = kr[u_]; *(LAS u32x4*)(Vb + o_) = vr[u_]; } } while (0)
        ATT_GLOAD(j0); ATT_LSTORE(j0 & 1);
        __syncthreads();
        float m_run = -3.0e38f, l_run = 0.f;
        f32x4 o[8];
#pragma unroll
        for (int dt = 0; dt < 8; ++dt) o[dt] = (f32x4){0.f, 0.f, 0.f, 0.f};
        const int cq = 16 * (wave & 3) + i;
        float qscale = 0.08838834764831845f; asm volatile("" : "+v"(qscale));
        for (int j = j0; j < 10; ++j) {
            if (j + 1 < 10) ATT_GLOAD(j + 1);
            const int jt = j - grp;
            if (jt >= 0 && jt <= 8) {
                const LAS unsigned char* Kt = Kb + (j & 1) * T64x128; const LAS unsigned char* Vt = Vb + (j & 1) * T64x128;
                f32x4 sc[4];
#pragma unroll
                for (int mt = 0; mt < 4; ++mt) { sc[mt] = (f32x4){0.f, 0.f, 0.f, 0.f};
#pragma unroll
                    for (int s = 0; s < 4; ++s) sc[mt] = MFMA16(frag_row(Kt, P128, 16 * mt, 32 * s, lane), qf[s], sc[mt]); }
                float mxv = -3.0e38f;
                if (jt <= 5) { const float bb = bs[256];
#pragma unroll
                    for (int mt = 0; mt < 4; ++mt)
#pragma unroll
                        for (int r = 0; r < 4; ++r) { sc[mt][r] = sc[mt][r] * qscale + bb; mxv = fmaxf(mxv, sc[mt][r]); }
                } else {
#pragma unroll
                    for (int mt = 0; mt < 4; ++mt)
#pragma unroll
                        for (int r = 0; r < 4; ++r) { int rel = 512 + cq - 64 * jt - (16 * mt + 4 * g + r); rel = rel > 128 ? 128 : rel;
                            sc[mt][r] = sc[mt][r] * qscale + bs[rel + 128]; mxv = fmaxf(mxv, sc[mt][r]); }
                }
                mxv = fmaxf(mxv, sx16(mxv)); mxv = fmaxf(mxv, sx32(mxv, lane));
                const float m_new = fmaxf(m_run, mxv), alpha = __expf(m_run - m_new); m_run = m_new;
                float ls = 0.f;
#pragma unroll
                for (int mt = 0; mt < 4; ++mt)
#pragma unroll
                    for (int r = 0; r < 4; ++r) { sc[mt][r] = __expf(sc[mt][r] - m_new); ls += sc[mt][r]; }
                l_run = l_run * alpha + ls;
#pragma unroll
                for (int dt = 0; dt < 8; ++dt) o[dt] = o[dt] * alpha;
#pragma unroll
                for (int ks = 0; ks < 2; ++ks) { const bf16x8 pf = pack8(sc[2 * ks], sc[2 * ks + 1]);
#pragma unroll
                    for (int dt = 0; dt < 8; ++dt) o[dt] = MFMA16(frag_tr(Vt, P128, 32 * ks + 4 * g, 32 * ks + 16 + 4 * g, 16 * dt, lane), pf, o[dt]); }
            }
            if (j + 1 < 10) ATT_LSTORE((j + 1) & 1);
            __syncthreads();
        }
#undef ATT_GLOAD
#undef ATT_LSTORE
        float lt = l_run; lt += sx16(lt); lt += sx32(lt, lane);
        const float inv = 1.0f / lt; float ssq = 0.f;
#pragma unroll
        for (int dt = 0; dt < 8; ++dt) { o[dt] = o[dt] * inv; ssq += (o[dt][0] * o[dt][0] + o[dt][1] * o[dt][1]) + (o[dt][2] * o[dt][2] + o[dt][3] * o[dt][3]); }
        ssq += sx16(ssq); ssq += sx32(ssq, lane);
        const float rs = rsqrtf(ssq * (1.0f / HD) + EPS);
        bf16* yo = Y + (tok0 + i) * D_ + 1280 + h * HD + 4 * g;
#pragma unroll
        for (int dt = 0; dt < 8; ++dt) { u32x2 w; w.x = cvt_pk_bf16(o[dt][0] * rs, o[dt][1] * rs); w.y = cvt_pk_bf16(o[dt][2] * rs, o[dt][3] * rs); *(u32x2*)(yo + 16 * dt) = w; }
    }
}

__device__ __forceinline__ float lgam(int h) { return logf(1.0f - exp2f(-5.0f - (float)h)); }
__device__ __forceinline__ void unpack8(const u32x4& w, float (&f)[8]) {
    f[0] = __uint_as_float(w.x << 16); f[1] = __uint_as_float(w.x & 0xffff0000u); f[2] = __uint_as_float(w.y << 16); f[3] = __uint_as_float(w.y & 0xffff0000u);
    f[4] = __uint_as_float(w.z << 16); f[5] = __uint_as_float(w.z & 0xffff0000u); f[6] = __uint_as_float(w.w << 16); f[7] = __uint_as_float(w.w & 0xffff0000u); }
__device__ __forceinline__ u32x4 pack8f(const float (&f)[8]) { u32x4 w; w.x = cvt_pk_bf16(f[0], f[1]); w.y = cvt_pk_bf16(f[2], f[3]); w.z = cvt_pk_bf16(f[4], f[5]); w.w = cvt_pk_bf16(f[6], f[7]); return w; }
__device__ __forceinline__ void rot_store(const bf16* __restrict__ src, const float* __restrict__ cp, const float* __restrict__ sp, float scl, LAS unsigned char* dst) {
    float a[8], b[8], o1[8], o2[8]; unpack8(*(const u32x4*)src, a); unpack8(*(const u32x4*)(src + 64), b);
    const f32x4 c0 = *(const f32x4*)cp, c1 = *(const f32x4*)(cp + 4), s0 = *(const f32x4*)sp, s1 = *(const f32x4*)(sp + 4);
#pragma unroll
    for (int j = 0; j < 8; ++j) { const float c = j < 4 ? c0[j & 3] : c1[j & 3], sn = j < 4 ? s0[j & 3] : s1[j & 3]; o1[j] = (a[j] * c - b[j] * sn) * scl; o2[j] = (a[j] * sn + b[j] * c) * scl; }
    *(LAS u32x4*)dst = pack8f(o1); *(LAS u32x4*)(dst + 128) = pack8f(o2);
}
__device__ __forceinline__ void ret_upd_items(LAS unsigned char* lds, const bf16* __restrict__ Z, const float* __restrict__ ROT, float* __restrict__ U, int G, int bx, int wave, int lane) {
    LAS unsigned char* Kz = lds; LAS unsigned char* Vt = lds + T64x128;
    const int i = lane & 15, g = lane >> 4, tid = wave * 64 + lane;
    for (int item = bx; item < B_ * RET_H * NCH; item += G) {
        const int n = item & 127, bh = item >> 7, h = bh % RET_H, b = bh / RET_H; const float lg = lgam(h);
        { const int l = tid >> 3, ch = tid & 7, pos = n * CH + l; const size_t row = (size_t)b * S_ + pos; float ksc = 0.08838834764831845f; asm volatile("" : "+v"(ksc));
          rot_store(Z + row * ZLD + O_RK + h * HD + 8 * ch, ROT + (size_t)pos * 64 + 8 * ch, ROT + (size_t)S_ * 64 + (size_t)pos * 64 + 8 * ch, ksc * __expf(lg * (float)(63 - l)), Kz + l * P128 + 16 * ch); }
#pragma unroll
        for (int u = 0; u < 2; ++u) { const int c = tid + NTHR * u; *(LAS u32x4*)(Vt + (c >> 4) * P128 + (c & 15) * 16) = *(const u32x4*)(Z + ((size_t)b * S_ + n * CH + (c >> 4)) * ZLD + O_RV + h * HD + (c & 15) * 8); }
        __syncthreads();
        f32x4 acc[8];
#pragma unroll
        for (int et = 0; et < 8; ++et) acc[et] = (f32x4){0.f, 0.f, 0.f, 0.f};
#pragma unroll
        for (int ks = 0; ks < 2; ++ks) { const bf16x8 af = frag_tr(Kz, P128, 32 * ks + 8 * g, 32 * ks + 8 * g + 4, 16 * wave, lane);
#pragma unroll
            for (int et = 0; et < 8; ++et) acc[et] = MFMA16(af, frag_tr(Vt, P128, 32 * ks + 8 * g, 32 * ks + 8 * g + 4, 16 * et, lane), acc[et]); }
        float* Uo = U + (size_t)item * 16384 + (size_t)(16 * wave + 4 * g) * 128 + i;
#pragma unroll
        for (int et = 0; et < 8; ++et)
#pragma unroll
            for (int r = 0; r < 4; ++r) Uo[r * 128 + 16 * et] = acc[et][r];
        __syncthreads();
    }
}
__device__ __forceinline__ float gla_decay(LAS float* gaL, LAS float* tot, const bf16* __restrict__ Z, size_t row0, const float* __restrict__ Wa, const float* __restrict__ ba, int h, int tid, float (&bcd)[8]) {
    if (tid < 128) { float f[8]; unpack8(*(const u32x4*)(Z + (row0 + (tid >> 1)) * ZLD + O_GA + 8 * (tid & 1)), f);
#pragma unroll
        for (int j = 0; j < 8; ++j) gaL[(tid >> 1) * 16 + 8 * (tid & 1) + j] = f[j]; }
    const int d = tid & 63, blk = tid >> 6;
    float w[GRANK];
#pragma unroll
    for (int r = 0; r < GRANK; ++r) w[r] = Wa[r * 256 + h * 64 + d];
    const float bb = ba[h * 64 + d];
    __syncthreads();
    float cum = 0.f;
#pragma unroll
    for (int i8 = 0; i8 < 8; ++i8) { float x = bb;
#pragma unroll
        for (int r = 0; r < GRANK; ++r) x += gaL[(8 * blk + i8) * 16 + r] * w[r];
        const float ls = fminf(x, 0.f) - log1pf(__expf(-fabsf(x)));
        cum += ls * (1.0f / 16.0f); bcd[i8] = cum; }
    tot[blk * 64 + d] = cum;
    __syncthreads();
    float pre = 0.f, blast = 0.f;
#pragma unroll
    for (int b2 = 0; b2 < 8; ++b2) { const float t = tot[b2 * 64 + d]; blast += t; pre += (b2 < blk) ? t : 0.f; }
#pragma unroll
    for (int i8 = 0; i8 < 8; ++i8) bcd[i8] += pre;
    return blast;
}
__device__ __forceinline__ void gla_upd_items(LAS unsigned char* lds, const bf16* __restrict__ Z, const float* __restrict__ Wa, const float* __restrict__ ba, float* __restrict__ Ug, float* __restrict__ Gg, int G, int bx, int wave, int lane) {
    LAS unsigned char* Ku = lds; LAS unsigned char* Vt = lds + 64 * P64; LAS float* gaL = (LAS float*)(lds + 64 * P64 + T64x128); LAS float* tot = gaL + 1024;
    const int i = lane & 15, g = lane >> 4, tid = wave * 64 + lane;
    for (int item = bx; item < B_ * GLA_H * NCH; item += G) {
        const int n = item & 127, bh = item >> 7, h = bh & 3, b = bh >> 2; const size_t row0 = (size_t)b * S_ + n * CH;
#pragma unroll
        for (int u = 0; u < 2; ++u) { const int c = tid + NTHR * u; *(LAS u32x4*)(Vt + (c >> 4) * P128 + (c & 15) * 16) = *(const u32x4*)(Z + (row0 + (c >> 4)) * ZLD + O_GV + h * GDV + (c & 15) * 8); }
        float bcd[8]; const float blast = gla_decay(gaL, tot, Z, row0, Wa, ba, h, tid, bcd);
        const int d = tid & 63, blk = tid >> 6;
#pragma unroll
        for (int i8 = 0; i8 < 8; ++i8) { const int c = 8 * blk + i8; const float kv = bf2f(Z[(row0 + c) * ZLD + O_GK + h * GDK + d]);
            *(LAS bf16*)(Ku + c * P64 + 2 * d) = (bf16)f2bf(kv * __expf(blast - bcd[i8])); }
        if (blk == 0) Gg[(size_t)item * 64 + d] = __expf(blast);
        __syncthreads();
        const int dtile = wave & 3, eq = wave >> 2;
        f32x4 acc[4];
#pragma unroll
        for (int e4 = 0; e4 < 4; ++e4) acc[e4] = (f32x4){0.f, 0.f, 0.f, 0.f};
#pragma unroll
        for (int ks = 0; ks < 2; ++ks) { const bf16x8 af = frag_tr(Ku, P64, 32 * ks + 8 * g, 32 * ks + 8 * g + 4, 16 * dtile, lane);
#pragma unroll
            for (int e4 = 0; e4 < 4; ++e4) acc[e4] = MFMA16(af, frag_tr(Vt, P128, 32 * ks + 8 * g, 32 * ks + 8 * g + 4, 16 * (eq * 4 + e4), lane), acc[e4]); }
        float* Uo = Ug + (size_t)item * 8192 + (size_t)(16 * dtile + 4 * g) * 128 + 64 * eq + i;
#pragma unroll
        for (int e4 = 0; e4 < 4; ++e4)
#pragma unroll
            for (int r = 0; r < 4; ++r) Uo[r * 128 + 16 * e4] = acc[e4][r];
        __syncthreads();
    }
}
__device__ __forceinline__ void scan_items(const float* __restrict__ Ur, bf16* __restrict__ Sr, const float* __restrict__ Ug, const float* __restrict__ Gg, bf16* __restrict__ Sg, int mixf, int G, int bx, int tid) {
    constexpr int NRET = 12 * 128 * 64, NALL = NRET + 8 * 64 * 64;
    for (int task = bx * NTHR + tid; task < NALL; task += G * NTHR) {
        if (task < NRET) { if (!(mixf & 2)) continue;
            const int e2 = task & 63, d = (task >> 6) & 127, bh = task >> 13; const float dec = __expf(lgam(bh % RET_H) * 64.0f);
            const float* up = Ur + (size_t)bh * NCH * 16384 + d * 128 + 2 * e2; bf16* sp = Sr + (size_t)bh * NCH * 16384 + d * 128 + 2 * e2;
            float s0 = 0.f, s1 = 0.f;
#pragma unroll 8
            for (int n = 0; n < NCH; ++n) { const f32x2 u = *(const f32x2*)(up + (size_t)n * 16384); *(unsigned*)(sp + (size_t)n * 16384) = cvt_pk_bf16(s0, s1); s0 = dec * s0 + u[0]; s1 = dec * s1 + u[1]; }
        } else { if (!(mixf & 4)) continue;
            const int t2 = task - NRET, e2 = t2 & 63, d = (t2 >> 6) & 63, bh = t2 >> 12;
            const float* up = Ug + (size_t)bh * NCH * 8192 + d * 128 + 2 * e2; bf16* sp = Sg + (size_t)bh * NCH * 8192 + d * 128 + 2 * e2; const float* gp = Gg + (size_t)bh * NCH * 64 + d;
            float s0 = 0.f, s1 = 0.f;
#pragma unroll 8
            for (int n = 0; n < NCH; ++n) { const f32x2 u = *(const f32x2*)(up + (size_t)n * 8192); const float gd = gp[n * 64]; *(unsigned*)(sp + (size_t)n * 8192) = cvt_pk_bf16(s0, s1); s0 = gd * s0 + u[0]; s1 = gd * s1 + u[1]; }
        }
    }
}
__device__ __forceinline__ void ret_out_items(LAS unsigned char* lds, const bf16* __restrict__ Z, const float* __restrict__ ROT, const bf16* __restrict__ Sr, bf16* __restrict__ Y, int G, int bx, int wave, int lane) {
    LAS unsigned char* Qr = lds; LAS unsigned char* Kr = lds + T64x128; LAS unsigned char* Vt = lds + 2 * T64x128; LAS unsigned char* St = lds + 3 * T64x128; LAS float* stat = (LAS float*)(lds + 3 * T64x128 + 128 * P128);
    const int i = lane & 15, g = lane >> 4, tid = wave * 64 + lane;
    for (int item = bx; item < B_ * RET_H * NCH; item += G) {
        const int n = item & 127, bh = item >> 7, h = bh % RET_H, b = bh / RET_H; const float lg = lgam(h); const size_t row0 = (size_t)b * S_ + n * CH;
        { const int l = tid >> 3, ch = tid & 7, pos = n * CH + l; const float* cp = ROT + (size_t)pos * 64 + 8 * ch; const float* sp = cp + (size_t)S_ * 64;
          rot_store(Z + (row0 + l) * ZLD + O_RQ + h * HD + 8 * ch, cp, sp, 1.0f, Qr + l * P128 + 16 * ch);
          float ksc = 0.08838834764831845f; asm volatile("" : "+v"(ksc));
          rot_store(Z + (row0 + l) * ZLD + O_RK + h * HD + 8 * ch, cp, sp, ksc, Kr + l * P128 + 16 * ch); }
#pragma unroll
        for (int u = 0; u < 2; ++u) { const int c = tid + NTHR * u; *(LAS u32x4*)(Vt + (c >> 4) * P128 + (c & 15) * 16) = *(const u32x4*)(Z + (row0 + (c >> 4)) * ZLD + O_RV + h * HD + (c & 15) * 8); }
#pragma unroll
        for (int u = 0; u < 4; ++u) { const int c = tid + NTHR * u; *(LAS u32x4*)(St + (c >> 4) * P128 + (c & 15) * 16) = *(const u32x4*)(Sr + (size_t)item * 16384 + (c >> 4) * 128 + (c & 15) * 8); }
        __syncthreads();
        const int ct = wave & 3, eh = wave >> 2, c = 16 * ct + i;
        bf16x8 qf[4];
#pragma unroll
        for (int s = 0; s < 4; ++s) qf[s] = frag_row(Qr, P128, 16 * ct, 32 * s, lane);
        f32x4 sc[4];
#pragma unroll
        for (int mt = 0; mt < 4; ++mt) { sc[mt] = (f32x4){0.f, 0.f, 0.f, 0.f};
#pragma unroll
            for (int s = 0; s < 4; ++s) sc[mt] = MFMA16(frag_row(Kr, P128, 16 * mt, 32 * s, lane), qf[s], sc[mt]);
#pragma unroll
            for (int r = 0; r < 4; ++r) { const int l = 16 * mt + 4 * g + r; sc[mt][r] *= __expf(lg * (float)(c > l ? c - l : l - c)); } }
        f32x4 o[4];
#pragma unroll
        for (int et = 0; et < 4; ++et) o[et] = (f32x4){0.f, 0.f, 0.f, 0.f};
#pragma unroll
        for (int ks = 0; ks < 4; ++ks)
#pragma unroll
            for (int et = 0; et < 4; ++et) o[et] = MFMA16(frag_tr(St, P128, 32 * ks + 8 * g, 32 * ks + 8 * g + 4, eh * 64 + 16 * et, lane), qf[ks], o[et]);
        const float xi = __expf(lg * (float)(c + 1));
#pragma unroll
        for (int et = 0; et < 4; ++et) o[et] = o[et] * xi;
#pragma unroll
        for (int ks = 0; ks < 2; ++ks) { const bf16x8 pf = pack8(sc[2 * ks], sc[2 * ks + 1]);
#pragma unroll
            for (int et = 0; et < 4; ++et) o[et] = MFMA16(frag_tr(Vt, P128, 32 * ks + 4 * g, 32 * ks + 16 + 4 * g, eh * 64 + 16 * et, lane), pf, o[et]); }
        float s1 = 0.f, s2 = 0.f;
#pragma unroll
        for (int et = 0; et < 4; ++et)
#pragma unroll
            for (int r = 0; r < 4; ++r) { s1 += o[et][r]; s2 += o[et][r] * o[et][r]; }
        s1 += sx16(s1); s1 += sx32(s1, lane); s2 += sx16(s2); s2 += sx32(s2, lane);
        if (g == 0) { stat[(eh * 64 + c) * 2] = s1; stat[(eh * 64 + c) * 2 + 1] = s2; }
        __syncthreads();
        s1 += stat[((eh ^ 1) * 64 + c) * 2]; s2 += stat[((eh ^ 1) * 64 + c) * 2 + 1];
        const float mu = s1 * (1.0f / HD), rs = rsqrtf(s2 * (1.0f / HD) - mu * mu + EPS);
        const bf16* gp = Z + (row0 + c) * ZLD + O_RG + h * HD + eh * 64 + 4 * g; bf16* yo = Y + (row0 + c) * D_ + h * HD + eh * 64 + 4 * g;
#pragma unroll
        for (int et = 0; et < 4; ++et) { const u32x2 gw = *(const u32x2*)(gp + 16 * et);
            const float g0 = __uint_as_float(gw.x << 16), g1 = __uint_as_float(gw.x & 0xffff0000u), g2 = __uint_as_float(gw.y << 16), g3 = __uint_as_float(gw.y & 0xffff0000u);
            u32x2 w; w.x = cvt_pk_bf16((o[et][0] - mu) * rs * silu_f(g0), (o[et][1] - mu) * rs * silu_f(g1)); w.y = cvt_pk_bf16((o[et][2] - mu) * rs * silu_f(g2), (o[et][3] - mu) * rs * silu_f(g3));
            *(u32x2*)(yo + 16 * et) = w; }
        __syncthreads();
    }
}
__device__ __forceinline__ void gla_out_items(LAS unsigned char* lds, const bf16* __restrict__ Z, const float* __restrict__ Wa, const float* __restrict__ ba, const bf16* __restrict__ Sg, bf16* __restrict__ Y, int G, int bx, int wave, int lane) {
    LAS unsigned char* Qi = lds; LAS unsigned char* Ki = lds + 64 * P64; LAS unsigned char* Vt = lds + 2 * 64 * P64; LAS unsigned char* St = Vt + T64x128;
    LAS float* gaL = (LAS float*)(St + T64x128); LAS float* tot = gaL + 1024; LAS float* stat = tot + 512;
    const int i = lane & 15, g = lane >> 4, tid = wave * 64 + lane;
    for (int item = bx; item < B_ * GLA_H * NCH; item += G) {
        const int n = item & 127, bh = item >> 7, h = bh & 3, b = bh >> 2; const size_t row0 = (size_t)b * S_ + n * CH;
#pragma unroll
        for (int u = 0; u < 2; ++u) { const int c = tid + NTHR * u; *(LAS u32x4*)(Vt + (c >> 4) * P128 + (c & 15) * 16) = *(const u32x4*)(Z + (row0 + (c >> 4)) * ZLD + O_GV + h * GDV + (c & 15) * 8);
            *(LAS u32x4*)(St + (c >> 4) * P128 + (c & 15) * 16) = *(const u32x4*)(Sg + (size_t)item * 8192 + (c >> 4) * 128 + (c & 15) * 8); }
        float bcd[8]; (void)gla_decay(gaL, tot, Z, row0, Wa, ba, h, tid, bcd);
        { const int d = tid & 63, blk = tid >> 6;
#pragma unroll
          for (int i8 = 0; i8 < 8; ++i8) { const int c = 8 * blk + i8; const float qv = bf2f(Z[(row0 + c) * ZLD + O_GQ + h * GDK + d]), kv = bf2f(Z[(row0 + c) * ZLD + O_GK + h * GDK + d]);
              *(LAS bf16*)(Qi + c * P64 + 2 * d) = (bf16)f2bf(qv * 0.125f * __expf(bcd[i8])); *(LAS bf16*)(Ki + c * P64 + 2 * d) = (bf16)f2bf(kv * __expf(-bcd[i8])); } }
        __syncthreads();
        const int ct = wave & 3, eh = wave >> 2, c = 16 * ct + i;
        bf16x8 qf[2];
#pragma unroll
        for (int s = 0; s < 2; ++s) qf[s] = frag_row(Qi, P64, 16 * ct, 32 * s, lane);
        f32x4 sc[4];
#pragma unroll
        for (int mt = 0; mt < 4; ++mt) { sc[mt] = (f32x4){0.f, 0.f, 0.f, 0.f};
#pragma unroll
            for (int s = 0; s < 2; ++s) sc[mt] = MFMA16(frag_row(Ki, P64, 16 * mt, 32 * s, lane), qf[s], sc[mt]);
#pragma unroll
            for (int r = 0; r < 4; ++r) { const int l = 16 * mt + 4 * g + r; sc[mt][r] = (c >= l) ? sc[mt][r] : 0.f; } }
        f32x4 o[4];
#pragma unroll
        for (int et = 0; et < 4; ++et) o[et] = (f32x4){0.f, 0.f, 0.f, 0.f};
#pragma unroll
        for (int ks = 0; ks < 2; ++ks)
#pragma unroll
            for (int et = 0; et < 4; ++et) o[et] = MFMA16(frag_tr(St, P128, 32 * ks + 8 * g, 32 * ks + 8 * g + 4, eh * 64 + 16 * et, lane), qf[ks], o[et]);
#pragma unroll
        for (int ks = 0; ks < 2; ++ks) { const bf16x8 pf = pack8(sc[2 * ks], sc[2 * ks + 1]);
#pragma unroll
            for (int et = 0; et < 4; ++et) o[et] = MFMA16(frag_tr(Vt, P128, 32 * ks + 4 * g, 32 * ks + 16 + 4 * g, eh * 64 + 16 * et, lane), pf, o[et]); }
        float s2 = 0.f;
#pragma unroll
        for (int et = 0; et < 4; ++et)
#pragma unroll
            for (int r = 0; r < 4; ++r) s2 += o[et][r] * o[et][r];
        s2 += sx16(s2); s2 += sx32(s2, lane);
        if (g == 0) stat[eh * 64 + c] = s2;
        __syncthreads();
        s2 += stat[(eh ^ 1) * 64 + c];
        const float rs = rsqrtf(s2 * (1.0f / GDV) + EPS);
        const bf16* gp = Z + (row0 + c) * ZLD + O_GG + h * GDV + eh * 64 + 4 * g; bf16* yo = Y + (row0 + c) * D_ + 768 + h * GDV + eh * 64 + 4 * g;
#pragma unroll
        for (int et = 0; et < 4; ++et) { const u32x2 gw = *(const u32x2*)(gp + 16 * et);
            const float g0 = __uint_as_float(gw.x << 16), g1 = __uint_as_float(gw.x & 0xffff0000u), g2 = __uint_as_float(gw.y << 16), g3 = __uint_as_float(gw.y & 0xffff0000u);
            u32x2 w; w.x = cvt_pk_bf16(o[et][0] * rs * silu_f(g0), o[et][1] * rs * silu_f(g1)); w.y = cvt_pk_bf16(o[et][2] * rs * silu_f(g2), o[et][3] * rs * silu_f(g3));
            *(u32x2*)(yo + 16 * et) = w; }
        __syncthreads();
    }
}
}

#define XB_TMO      128
#define XB_XCNT(j)  (256  + 64 * (j))
#define XB_XSUB(j)  (1280 + 64 * (j))
#define XB_XGEN(j)  (2304 + 64 * (j))
#define XB_TOP      3328
#define XB_TOPGEN   3392
#define XCD_BAR_WORDS 3456
#define XB_SPIN_CAP (1u << 18)
__device__ __forceinline__ unsigned xb_ld(unsigned* p)              { return __hip_atomic_load(p, __ATOMIC_RELAXED, __HIP_MEMORY_SCOPE_AGENT); }
__device__ __forceinline__ unsigned xb_add(unsigned* p, unsigned v) { return __hip_atomic_fetch_add(p, v, __ATOMIC_RELAXED, __HIP_MEMORY_SCOPE_AGENT); }
__device__ __forceinline__ unsigned xb_xcc_id() { return (unsigned)__builtin_amdgcn_s_getreg((3 << 11) | 20) & 0xFu; }
#define XB_SPIN(cond, bar) do { unsigned _sp = 0; while (cond) { __builtin_amdgcn_s_sleep(1); \
    if ((++_sp & 255u) == 0u) { if (xb_ld(&(bar)[XB_TMO])) break; if (_sp > XB_SPIN_CAP) { atomicAdd(&(bar)[XB_TMO], 1u); break; } } } } while (0)
struct XcdBarrier { unsigned* bar; unsigned x; volatile LAS unsigned* st; };
__device__ __forceinline__ XcdBarrier xcd_barrier_post(unsigned* bar, volatile LAS unsigned* st) {
    XcdBarrier b; b.bar = bar; b.x = xb_xcc_id(); b.st = st;
    if (threadIdx.x == 0) (void)xb_add(&bar[XB_XCNT(b.x)], 1u);
    return b;
}
__device__ __forceinline__ void xcd_barrier_complete(unsigned* bar, unsigned x, unsigned& nloc, unsigned& nx) {
    const unsigned G = gridDim.x * gridDim.y * gridDim.z;
    unsigned sum, cnt, mine, sp = 0u;
    for (;;) {
        sum = 0u; cnt = 0u; mine = 0u;
#pragma unroll
        for (unsigned j = 0; j < 16; ++j) { const unsigned c = xb_ld(&bar[XB_XCNT(j)]); sum += c; cnt += (c > 0u) ? 1u : 0u; mine = (j == x) ? c : mine; }
        if (sum == G) break;
        __builtin_amdgcn_s_sleep(1);
        if ((++sp & 255u) == 0u) { if (xb_ld(&bar[XB_TMO])) break; if (sp > XB_SPIN_CAP) { atomicAdd(&bar[XB_TMO], 1u); break; } }
    }
    nloc = mine > 0u ? mine : 1u; nx = cnt > 0u ? cnt : 1u;
}
__device__ __forceinline__ void xcd_barrier(const XcdBarrier& b) {
    asm volatile("s_waitcnt vmcnt(0)" ::: "memory");
    __syncthreads();
    if (threadIdx.x == 0) {
        unsigned* bar = b.bar;
        __builtin_amdgcn_s_waitcnt(0);
        unsigned nloc = b.st[0], nx = b.st[1];
        if (nloc == 0u) { xcd_barrier_complete(bar, b.x, nloc, nx); b.st[0] = nloc; b.st[1] = nx; }
        const unsigned old = xb_add(&bar[XB_XSUB(b.x)], 1u);
        const unsigned gen = old / nloc;
        if (old + 1u == (gen + 1u) * nloc) {
            __builtin_amdgcn_fence(__ATOMIC_RELEASE, "agent");
            asm volatile("s_waitcnt vmcnt(0)" ::: "memory");
            const unsigned og = xb_add(&bar[XB_TOP], 1u);
            const unsigned tg = og / nx;
            if (og + 1u == (tg + 1u) * nx) xb_add(&bar[XB_TOPGEN], 1u);
            else XB_SPIN(xb_ld(&bar[XB_TOPGEN]) == tg, bar);
            __builtin_amdgcn_fence(__ATOMIC_ACQUIRE, "agent");
            xb_add(&bar[XB_XGEN(b.x)], 1u);
            asm volatile("s_waitcnt vmcnt(0)" ::: "memory");
        } else {
            XB_SPIN(xb_ld(&bar[XB_XGEN(b.x)]) == gen, bar);
            __builtin_amdgcn_fence(__ATOMIC_ACQUIRE, "agent");
            asm volatile("s_waitcnt vmcnt(0)" ::: "memory");
        }
    }
    __syncthreads();
}

constexpr int RING_OFF = 0, RING_BYTES = 131072;
constexpr int MISC_OFF = RING_BYTES;
constexpr int LDS_BYTES = 147456;

struct Args { const float* in[21]; float* out; unsigned char* ws; int l_lo, l_hi, ph_lo, ph_hi, do_pro, do_fin, use_bar, mix; };

template <class RowMap>
__device__ __forceinline__ void transpose_item(const float* __restrict__ W, int ldn, int nmax, int k0, int n0, const float* __restrict__ s, bf16* __restrict__ WT, int ldk, int dk0, RowMap drow, LAS float* scr, int lane) {
#pragma unroll 8
    for (int i = 0; i < 32; ++i) { const int kk = 2 * i + (lane >> 5), n = n0 + (lane & 31);
        float v = (n < nmax) ? W[(size_t)(k0 + kk) * ldn + n] : 0.f; if (s) v *= s[k0 + kk];
        scr[kk * 33 + (lane & 31)] = v; }
    LDS_WAIT(); asm volatile("" ::: "memory");
    const int c = lane & 7;
#pragma unroll
    for (int j = 0; j < 4; ++j) { const int nl = (lane >> 3) + 8 * j, n = n0 + nl; const LAS float* sp = scr + (8 * c) * 33 + nl;
        u32x4 o; o.x = pk2(sp[0 * 33], sp[1 * 33]); o.y = pk2(sp[2 * 33], sp[3 * 33]); o.z = pk2(sp[4 * 33], sp[5 * 33]); o.w = pk2(sp[6 * 33], sp[7 * 33]);
        if (n < nmax) *(u32x4*)(WT + (size_t)drow(n) * ldk + dk0 + k0 + 8 * c) = o; }
    LDS_WAIT(); asm volatile("" ::: "memory");
}

typedef const __attribute__((address_space(4))) Args* CArgsP;
__device__ __forceinline__ CArgsP argp() {
    unsigned long long v = (unsigned long long)(CArgsP)__builtin_amdgcn_kernarg_segment_ptr(); unsigned lo = (unsigned)v, hi = (unsigned)(v >> 32);
    asm volatile("" : "+s"(lo), "+s"(hi));
    lo = __builtin_amdgcn_readfirstlane(lo); hi = __builtin_amdgcn_readfirstlane(hi);
    return (CArgsP)(((unsigned long long)hi << 32) | lo);
}
__global__ void __launch_bounds__(NTHR, 2) mk_fwd(Args args_unused) {
    extern __shared__ __attribute__((aligned(16))) unsigned char lds_raw[];
    LAS unsigned char* lds = (LAS unsigned char*)lds_raw;
    volatile LAS unsigned* MISC = (volatile LAS unsigned*)(lds + MISC_OFF);
    for (int u = threadIdx.x; u < 256; u += NTHR) MISC[u] = 0u;
    const int wave_s = __builtin_amdgcn_readfirstlane(threadIdx.x >> 6);
    __syncthreads();
    if (argp()->use_bar) (void)xcd_barrier_post((unsigned*)(argp()->ws + WS_CTL) + CW_BAR, MISC + 8);
#define GRID_BAR() do { CArgsP ap_ = argp(); if (ap_->use_bar) { XcdBarrier bar_; bar_.bar = (unsigned*)(ap_->ws + WS_CTL) + CW_BAR; bar_.x = xb_xcc_id(); bar_.st = MISC + 8; xcd_barrier(bar_); } } while (0)
#define PHASE_VARS() CArgsP ap = argp(); unsigned char* ws = ap->ws; float* ssb = (float*)(ws + WS_SSP); float* X = ap->out; \
    const int G = gridDim.x, bx = blockIdx.x; (void)ssb; (void)X; (void)G; (void)bx
#define WAVE_VARS() const int lane = lane_opaque(), wave = wave_s; \
    const int vcu = (G % 8 == 0) ? (bx % 8) * (G / 8) + bx / 8 : bx; const int gw = vcu * NWAVES + wave, NGW = G * NWAVES; (void)lane; (void)gw; (void)NGW

    if (argp()->do_pro) {
        PHASE_VARS(); WAVE_VARS();
        LAS float* scr = (LAS float*)(lds + RING_OFF + wave * 16384);
        for (int l = 0; l < DEPTH_; ++l) {
            { const float* W = ap->in[3] + (size_t)l * D_ * DIN; const float* s = ap->in[2] + l * D_; bf16* WT = (bf16*)(ws + WS_WIN) + (size_t)l * ZLD * D_;
              constexpr int NB = (DIN + 31) / 32;
              for (int it = gw; it < 32 * NB; it += NGW) { const int kb = it / NB, nb = it % NB;
                  transpose_item(W, DIN, DIN, kb * 64, nb * 32, s, WT, D_, 0, [](int n) { return n < 4608 ? n : (n < 4624 ? n + 2304 : n - 16); }, scr, lane); }
              for (int i = gw * 64 + lane; i < (ZLD - DIN) * D_ / 8; i += NGW * 64) *(u32x4*)(WT + (size_t)DIN * D_ + (size_t)i * 8) = (u32x4){0u, 0u, 0u, 0u}; }
            { const float* W = ap->in[8] + (size_t)l * D_ * D_; const float* s = ap->in[7] + l * D_; bf16* WT = (bf16*)(ws + WS_WOUT) + (size_t)l * D_ * D_;
              for (int it = gw; it < 32 * 64; it += NGW) transpose_item(W, D_, D_, (it / 64) * 64, (it % 64) * 32, s, WT, D_, 0, [](int n) { return n; }, scr, lane); }
            { const float* W = ap->in[18] + (size_t)l * D_ * D_; const float* s = ap->in[17] + l * D_; bf16* WT = (bf16*)(ws + WS_WPG) + (size_t)l * D_ * D_;
              for (int it = gw; it < 32 * 64; it += NGW) transpose_item(W, D_, D_, (it / 64) * 64, (it % 64) * 32, s, WT, D_, 0, [](int n) { return n; }, scr, lane); }
            { const float* W = ap->in[19] + (size_t)l * PLE * D_; bf16* WT = (bf16*)(ws + WS_WPP) + (size_t)l * D_ * PLE;
              for (int it = gw; it < 4 * 64; it += NGW) transpose_item(W, D_, D_, (it / 64) * 64, (it % 64) * 32, (const float*)nullptr, WT, PLE, 0, [](int n) { return n; }, scr, lane); }
        }
        for (int l = 0; l < DEPTH_; ++l) {
            { const float* s = ap->in[9] + l * D_;
              for (int it = gw; it < 32 * 2 * 256; it += NGW) { const int ge = it >> 9, mat = (it >> 8) & 1, kb = (it & 255) >> 3, nb = it & 7;
                  const float* W = ap->in[14 + mat] + ((size_t)l * 32 + ge) * D_ * FF; bf16* WT = (bf16*)(ws + WS_WGU) + ((size_t)l * 32 + ge) * 512 * D_;
                  transpose_item(W, FF, FF, kb * 64, nb * 32, s, WT, D_, 0, [mat](int n) { return (n >> 7) * 256 + mat * 128 + (n & 127); }, scr, lane); } }
            { for (int it = gw; it < 32 * 256; it += NGW) { const int ge = it >> 8, kb = (it & 255) >> 6, nb = it & 63;
                  const float* W = ap->in[16] + ((size_t)l * 32 + ge) * FF * D_; bf16* WT = (bf16*)(ws + WS_WD) + ((size_t)l * 4 + (ge >> 3)) * D_ * D_;
                  transpose_item(W, D_, D_, kb * 64, nb * 32, (const float*)nullptr, WT, D_, (ge & 7) * 256, [](int n) { return n; }, scr, lane); } }
            { float* WR = (float*)(ws + WS_WR) + (size_t)l * 48 * D_; const float* s = ap->in[9] + l * D_; const float* wg = ap->in[10] + (size_t)l * D_ * 4; const float* we = ap->in[12] + (size_t)l * D_ * 32;
              for (int i = gw * 64 + lane; i < 48 * D_; i += NGW * 64) { const int j = i >> 11, k = i & 2047;
                  WR[i] = (j < 4) ? s[k] * wg[k * 4 + j] : (j < 36 ? s[k] * we[k * 32 + (j - 4)] : 0.f); } }
        }
        { float* RT = (float*)(ws + WS_ROT);
          for (int idx = gw * 64 + lane; idx < S_ * 64; idx += NGW * 64) { const float inv = 1.0f / powf(10000.0f, (float)(idx & 63) / 64.0f); float sn, cs; sincosf((float)(idx >> 6) * inv, &sn, &cs); RT[idx] = cs; RT[S_ * 64 + idx] = sn; } }
        { const float* P = ap->in[1]; bf16* PB = (bf16*)(ws + WS_PB);
          for (size_t i = (size_t)gw * 64 + lane; i < (size_t)DEPTH_ * T_ * PLE / 8; i += (size_t)NGW * 64) { const f32x4 a = *(const f32x4*)(P + i * 8), b = *(const f32x4*)(P + i * 8 + 4);
              u32x4 o; o.x = pk2(a[0], a[1]); o.y = pk2(a[2], a[3]); o.z = pk2(b[0], b[1]); o.w = pk2(b[2], b[3]); *(u32x4*)(PB + i * 8) = o; } }
        { const float* xin = ap->in[0]; bf16* XB = (bf16*)(ws + WS_XB0);
          for (int m = gw; m < T_; m += NGW) { const f32x4* xr = (const f32x4*)(xin + (size_t)m * D_) + lane; f32x4 v[8]; float s = 0.f;
#pragma unroll
              for (int j = 0; j < 8; ++j) { v[j] = xr[64 * j]; s += (v[j][0] * v[j][0] + v[j][1] * v[j][1]) + (v[j][2] * v[j][2] + v[j][3] * v[j][3]); }
              s = wave_sum(s);
#pragma unroll
              for (int j = 0; j < 8; ++j) { *((f32x4*)(X + (size_t)m * D_) + lane + 64 * j) = v[j]; u32x2 o; o.x = pk2(v[j][0], v[j][1]); o.y = pk2(v[j][2], v[j][3]); *((u32x2*)(XB + (size_t)m * D_) + lane + 64 * j) = o; }
              if (lane < 8) ssb[(size_t)lane * T_ + m] = (lane == 0) ? s : 0.f; } }
        GRID_BAR();
    }

    for (int l = argp()->l_lo; l < argp()->l_hi; ++l) {
#define IN(k) (argp()->ph_lo <= (k) && (k) < argp()->ph_hi)
#define LAYER_VARS() const int cur = l & 1; bf16* XBc = (bf16*)(ws + (cur ? WS_XB1 : WS_XB0)); bf16* XBn = (bf16*)(ws + (cur ? WS_XB0 : WS_XB1)); \
        float* ss0 = ssb + (size_t)(l * 3 + 0) * 8 * T_; float* ss1 = ssb + (size_t)(l * 3 + 1) * 8 * T_; float* ss2 = ssb + (size_t)(l * 3 + 2) * 8 * T_; float* ss3 = ssb + (size_t)(l * 3 + 3) * 8 * T_; \
        (void)XBc; (void)XBn; (void)ss0; (void)ss1; (void)ss2; (void)ss3
        if (IN(1)) {
            PHASE_VARS(); LAYER_VARS();
            pg8::DenseOrder S; S.init(XBc, (bf16*)(ws + WS_WIN) + (size_t)l * ZLD * D_, T_, ZLD, D_, D_, G, bx);
            pg8::EpiZ E{(bf16*)(ws + WS_Z), ss0};
            pg8::gemm_phase<pg8::EpiZ, pg8::DenseOrder, false, true>(lds + RING_OFF, wave_s, D_, D_, D_, S, E);
            GRID_BAR();
        }
        if (IN(2)) {
            PHASE_VARS(); WAVE_VARS();
            if (ap->mix & 1) mx::attn_items(lds + RING_OFF, (const bf16*)(ws + WS_Z), ap->in[6] + (size_t)l * ATT_H * 257, (bf16*)(ws + WS_Y), G, bx, wave, lane);
            if (ap->mix & 2) mx::ret_upd_items(lds + RING_OFF, (const bf16*)(ws + WS_Z), (const float*)(ws + WS_ROT), (float*)(ws + WS_SCR + SC_UR), G, bx, wave, lane);
            if (ap->mix & 4) mx::gla_upd_items(lds + RING_OFF, (const bf16*)(ws + WS_Z), ap->in[4] + (size_t)l * GRANK * 256, ap->in[5] + l * 256, (float*)(ws + WS_SCR + SC_UG), (float*)(ws + WS_SCR + SC_GG), G, bx, wave, lane);
            GRID_BAR();
        }
        if (IN(3)) {
            PHASE_VARS(); WAVE_VARS();
            mx::scan_items((const float*)(ws + WS_SCR + SC_UR), (bf16*)(ws + WS_SCR + SC_SR), (const float*)(ws + WS_SCR + SC_UG), (const float*)(ws + WS_SCR + SC_GG), (bf16*)(ws + WS_SCR + SC_SG), ap->mix, G, bx, wave * 64 + lane);
            GRID_BAR();
        }
        if (IN(4)) {
            PHASE_VARS(); WAVE_VARS();
            if (ap->mix & 2) mx::ret_out_items(lds + RING_OFF, (const bf16*)(ws + WS_Z), (const float*)(ws + WS_ROT), (const bf16*)(ws + WS_SCR + SC_SR), (bf16*)(ws + WS_Y), G, bx, wave, lane);
            if (ap->mix & 4) mx::gla_out_items(lds + RING_OFF, (const bf16*)(ws + WS_Z), ap->in[4] + (size_t)l * GRANK * 256, ap->in[5] + l * 256, (const bf16*)(ws + WS_SCR + SC_SG), (bf16*)(ws + WS_Y), G, bx, wave, lane);
            GRID_BAR();
        }
        if (IN(5)) {
            { PHASE_VARS(); LAYER_VARS();
              pg8::DenseOrder S; S.init(ws + WS_Y, (bf16*)(ws + WS_WOUT) + (size_t)l * D_ * D_, T_, D_, D_, D_, G, bx);
              pg8::EpiRes E{X, XBn, ss1, (LAS float*)(lds + MISC_OFF + 1024)};
              pg8::gemm_phase<pg8::EpiRes, pg8::DenseOrder, false, true>(lds + RING_OFF, wave_s, D_, D_, D_, S, E); }
            { PHASE_VARS();
              pg8::DenseOrder S; S.init((bf16*)(ws + WS_PB) + (size_t)l * T_ * PLE, (bf16*)(ws + WS_WPP) + (size_t)l * D_ * PLE, T_, D_, PLE, PLE, G, bx);
              pg8::EpiB E{(bf16*)(ws + WS_PROJ), D_};
              pg8::gemm_phase<pg8::EpiB, pg8::DenseOrder, false, true>(lds + RING_OFF, wave_s, PLE, PLE, PLE, S, E); }
            GRID_BAR();
        }
        if (IN(6)) {
            PHASE_VARS(); LAYER_VARS(); WAVE_VARS();
            const float* Wr = (const float*)(ws + WS_WR) + (size_t)l * 48 * D_;
            const float* brg = ap->in[11] + l * 4; const float* bre = ap->in[13] + l * 32;
            unsigned* cnt = (unsigned*)(ws + WS_CTL) + CW_CNT + l * 128;
            u32x4* ent = (u32x4*)(ws + WS_SCR + SC_ENT);
            LAS float* L = (LAS float*)(lds + RING_OFF);
            for (int grp0 = vcu * 4; grp0 < T_ / 16; grp0 += G * 4) {
                const int grp = grp0 + (wave >> 1), kh = wave & 1, i = lane & 15, q = lane >> 4;
                const float* xa = X + (size_t)(grp * 16 + i) * D_ + kh * 1024 + 4 * q;
                const float* wb = Wr + (size_t)i * D_ + kh * 1024 + 4 * q;
                f32x4 a0 = {0.f, 0.f, 0.f, 0.f}, a1 = a0, a2 = a0;
#pragma unroll 4
                for (int st = 0; st < 64; ++st) {
                    const f32x4 xv = *(const f32x4*)(xa + 16 * st), w0 = *(const f32x4*)(wb + 16 * st), w1 = *(const f32x4*)(wb + 16 * D_ + 16 * st), w2 = *(const f32x4*)(wb + 32 * D_ + 16 * st);
#pragma unroll
                    for (int c = 0; c < 4; ++c) { a0 = __builtin_amdgcn_mfma_f32_16x16x4f32(xv[c], w0[c], a0, 0, 0, 0); a1 = __builtin_amdgcn_mfma_f32_16x16x4f32(xv[c], w1[c], a1, 0, 0, 0); a2 = __builtin_amdgcn_mfma_f32_16x16x4f32(xv[c], w2[c], a2, 0, 0, 0); }
                }
                LAS float* Lw = L + ((wave >> 1) * 2 + kh) * 768;
#pragma unroll
                for (int r = 0; r < 4; ++r) { Lw[(4 * q + r) * 48 + i] = a0[r]; Lw[(4 * q + r) * 48 + 16 + i] = a1[r]; Lw[(4 * q + r) * 48 + 32 + i] = a2[r]; }
                __syncthreads();
                if (kh == 0 && lane < 16) {
                    const int tok = grp * 16 + lane; const float rs = row_rs(ss1, tok);
                    const LAS float* L0 = L + (wave >> 1) * 2 * 768 + lane * 48; const LAS float* L1 = L0 + 768;
                    float lg[36];
#pragma unroll
                    for (int j = 0; j < 36; ++j) lg[j] = (L0[j] + L1[j]) * rs;
                    float mx = -3e38f; int g = 0;
#pragma unroll
                    for (int j = 0; j < 4; ++j) { lg[j] += brg[j]; if (lg[j] > mx) { mx = lg[j]; g = j; } }
                    float sum = 0.f;
#pragma unroll
                    for (int j = 0; j < 4; ++j) sum += __expf(lg[j] - mx);
                    const float pg = 1.f / sum;
                    float el[8], m2 = -3e38f;
#pragma unroll
                    for (int e = 0; e < 8; ++e) { float v = 0.f;
#pragma unroll
                        for (int gg = 0; gg < 4; ++gg) v = (gg == g) ? lg[4 + gg * 8 + e] : v;
                        el[e] = v + bre[g * 8 + e]; m2 = fmaxf(m2, el[e]); }
                    int e1 = 0, e2 = 0; float p1 = -1.f, p2 = -1.f;
#pragma unroll
                    for (int e = 0; e < 8; ++e) { el[e] = __expf(el[e] - m2); if (el[e] > p1) { p1 = el[e]; e1 = e; } }
#pragma unroll
                    for (int e = 0; e < 8; ++e) if (e != e1 && el[e] > p2) { p2 = el[e]; e2 = e; }
                    const float wsum = p1 + p2; const float c1 = pg * (p1 / wsum), c2 = pg * (p2 / wsum);
                    const int ea = e1 < e2 ? e1 : e2, eb = e1 < e2 ? e2 : e1; const float ca = e1 < e2 ? c1 : c2, cb = e1 < e2 ? c2 : c1;
                    const int bucket = g * 28 + (ea * (15 - ea)) / 2 + (eb - ea - 1);
                    const unsigned rank = atomicAdd(cnt + bucket, 1u);
                    ent[(size_t)bucket * T_ + rank] = (u32x4){(unsigned)tok, __float_as_uint(ca), __float_as_uint(cb), __float_as_uint(rs)};
                }
                __syncthreads();
            }
            GRID_BAR();
        }
        if (IN(7)) {
            PHASE_VARS(); LAYER_VARS();
            LAS int* tb = (LAS int*)(lds + MISC_OFF + 6144);
            pg8::moe_build_table(tb, (const unsigned*)(ws + WS_CTL) + CW_CNT + l * 128, wave_s * 64 + lane_opaque());
            pg8::MoeOrder1 S{tb, (const char*)XBn, (const char*)((bf16*)(ws + WS_WGU) + (size_t)l * 32 * 512 * D_), (const u32x4*)(ws + WS_SCR + SC_ENT), G, bx};
            pg8::EpiHid E{(bf16*)(ws + WS_SCR + SC_HIDB), (const u32x4*)(ws + WS_SCR + SC_ENT)};
            pg8::gemm_phase<pg8::EpiHid, pg8::MoeOrder1, true, true>(lds + RING_OFF, wave_s, D_, D_, D_, S, E);
            GRID_BAR();
        }
        if (IN(8)) {
            PHASE_VARS(); LAYER_VARS();
            LAS int* tb = (LAS int*)(lds + MISC_OFF + 6144);
            pg8::moe_build_table(tb, (const unsigned*)(ws + WS_CTL) + CW_CNT + l * 128, wave_s * 64 + lane_opaque());
            pg8::MoeOrder2 S{tb, (const char*)(ws + WS_SCR + SC_HIDB), (const char*)((bf16*)(ws + WS_WD) + (size_t)l * 4 * D_ * D_), G, bx};
            pg8::EpiMoe2 E{X, XBc, ss2, (const u32x4*)(ws + WS_SCR + SC_ENT), (LAS float*)(lds + MISC_OFF + 1024)};
            pg8::gemm_phase<pg8::EpiMoe2, pg8::MoeOrder2, false, true>(lds + RING_OFF, wave_s, 512, 512, D_, S, E);
            GRID_BAR();
        }
        if (IN(9)) {
            PHASE_VARS(); LAYER_VARS();
            pg8::DenseOrder S; S.init(XBc, (bf16*)(ws + WS_WPG) + (size_t)l * D_ * D_, T_, D_, D_, D_, G, bx);
            pg8::EpiPle E{X, XBn, (const bf16*)(ws + WS_PROJ), ss2, ss3, (LAS float*)(lds + MISC_OFF + 1024)};
            pg8::gemm_phase<pg8::EpiPle, pg8::DenseOrder, false, true>(lds + RING_OFF, wave_s, D_, D_, D_, S, E);
            GRID_BAR();
        }
    }
    if (argp()->do_fin) {
        PHASE_VARS(); WAVE_VARS();
        const float* gf = ap->in[20]; const float* ssf = ssb + (size_t)(DEPTH_ * 3) * 8 * T_;
        for (int m = gw; m < T_; m += NGW) { f32x4* xr = (f32x4*)(X + (size_t)m * D_) + lane; const float rs = row_rs(ssf, m);
#pragma unroll
            for (int j = 0; j < 8; ++j) { const f32x4 g = *((const f32x4*)gf + lane + 64 * j); xr[64 * j] = xr[64 * j] * rs * g; } }
    }
#undef IN
}

static void launch_mk(Args a, int grid, hipStream_t stream) { hipLaunchKernelGGL(mk_fwd, dim3(grid), dim3(NTHR), LDS_BYTES, stream, a); }

extern "C" void kernel_launch(void* const* d_in, const int* in_sizes, int n_in, void* d_out, int out_size, void* d_ws, size_t ws_size, hipStream_t stream) {
    static int grid = 0;
    if (grid == 0) {
        int dev = 0, cus = 0;
        (void)hipGetDevice(&dev); (void)hipDeviceGetAttribute(&cus, hipDeviceAttributeMultiprocessorCount, dev);
        (void)hipFuncSetAttribute((const void*)mk_fwd, hipFuncAttributeMaxDynamicSharedMemorySize, LDS_BYTES);
        grid = cus > 0 ? cus : 256;
        if (ws_size < WS_END) { fprintf(stderr, "workspace too small: %zu < %zu\n", ws_size, (size_t)WS_END); grid = -1; }
    }
    if (grid < 0) return;
    unsigned char* ws = (unsigned char*)d_ws;
    (void)hipMemsetAsync(ws + WS_CTL, 0, CTL_BYTES, stream);
    Args a{};
    for (int i = 0; i < 21; ++i) a.in[i] = (const float*)d_in[i];
    a.out = (float*)d_out; a.ws = ws; a.use_bar = 0; a.mix = 1;
#if defined(MK_MULTI_LAUNCH)
    auto run = [&](int l, int ph, int pro, int fin) { Args b = a; b.l_lo = l; b.l_hi = (ph > 0) ? l + 1 : l; b.ph_lo = ph; b.ph_hi = ph + 1; b.do_pro = pro; b.do_fin = fin; launch_mk(b, grid, stream); };
    a.mix = 7;
    run(0, 0, 1, 0);
    for (int l = 0; l < DEPTH_; ++l) for (int ph = 1; ph <= 9; ++ph) run(l, ph, 0, 0);
    run(0, 0, 0, 1);
#else
    a.mix = 7; a.use_bar = 1; a.l_lo = 0; a.l_hi = DEPTH_; a.ph_lo = 1; a.ph_hi = 10; a.do_pro = 1; a.do_fin = 1;
    launch_mk(a, grid, stream);
#endif
}
```

```cpp
#include <hip/hip_runtime.h>
#include <math.h>
#include <stdio.h>

#define LAS __attribute__((address_space(3)))
#define GAS __attribute__((address_space(1)))
typedef unsigned short bf16;
typedef short bf16x8 __attribute__((ext_vector_type(8)));
typedef float f32x4 __attribute__((ext_vector_type(4)));
typedef float f32x2 __attribute__((ext_vector_type(2)));
typedef unsigned u32x4 __attribute__((ext_vector_type(4)));
typedef unsigned u32x2 __attribute__((ext_vector_type(2)));

constexpr int B_ = 2, S_ = 8192, T_ = B_ * S_, D_ = 2048, DEPTH_ = 4, DIN = 6928, ZLD = 7168, CH = 64, NCH = S_ / CH;
constexpr int RET_H = 6, GLA_H = 4, ATT_H = 6, HD = 128, GDK = 64, GDV = 128, GRANK = 16;
constexpr int O_RQ = 0, O_RK = 768, O_RV = 1536, O_RG = 2304, O_GQ = 3072, O_GK = 3328, O_GV = 3584, O_GG = 4096, O_AQ = 4608, O_AK = 5376, O_AV = 6144, O_GA = 6912;
constexpr int NG = 4, NE = 8, FF = 256, PLE = 256;
constexpr float EPS = 1e-6f;
constexpr int NWAVES = 8, NTHR = 512;

constexpr size_t MiB = 1u << 20;
constexpr size_t WS_CTL = 0, CTL_BYTES = 2 * MiB;
constexpr int CW_BAR = 1024;
constexpr int CW_CNT = 8192;
constexpr size_t SS_OFF = 256 * 1024;
constexpr size_t WS_WIN = WS_CTL + CTL_BYTES;
constexpr size_t WS_WOUT = WS_WIN + (size_t)DEPTH_ * ZLD * D_ * 2;
constexpr size_t WS_WPG = WS_WOUT + (size_t)DEPTH_ * D_ * D_ * 2;
constexpr size_t WS_WPP = WS_WPG + (size_t)DEPTH_ * D_ * D_ * 2;
constexpr size_t WS_WGU = WS_WPP + (size_t)DEPTH_ * D_ * PLE * 2;
constexpr size_t WS_WD = WS_WGU + (size_t)DEPTH_ * 32 * 512 * D_ * 2;
constexpr size_t WS_WR = WS_WD + (size_t)DEPTH_ * 4 * D_ * D_ * 2;
constexpr size_t WS_ROT = WS_WR + (size_t)DEPTH_ * 48 * D_ * 4;
constexpr size_t WS_SSP = WS_ROT + (size_t)2 * S_ * 64 * 4;
constexpr size_t WS_PB = WS_SSP + (size_t)13 * 8 * T_ * 4;
constexpr size_t WS_XB0 = WS_PB + (size_t)DEPTH_ * T_ * PLE * 2;
constexpr size_t WS_XB1 = WS_XB0 + (size_t)T_ * D_ * 2;
constexpr size_t WS_Z = WS_XB1 + (size_t)T_ * D_ * 2;
constexpr size_t WS_Y = WS_Z + (size_t)T_ * ZLD * 2;
constexpr size_t WS_SCR = WS_Y + (size_t)T_ * D_ * 2;
constexpr size_t SC_UR = 0;
constexpr size_t SC_SR = SC_UR + (size_t)12 * NCH * 128 * 128 * 4;
constexpr size_t SC_UG = SC_SR + (size_t)12 * NCH * 128 * 128 * 4;
constexpr size_t SC_SG = SC_UG + (size_t)8 * NCH * 64 * 128 * 4;
constexpr size_t SC_GG = SC_SG + (size_t)8 * NCH * 64 * 128 * 4;
constexpr size_t SC_BC = SC_GG + (size_t)8 * NCH * 64 * 4;
constexpr size_t SC_END = SC_BC + (size_t)T_ * 256 * 4;
constexpr size_t SC_ENT = 0;
constexpr size_t SC_HIDB = SC_ENT + (size_t)112 * T_ * 16;
static_assert(SC_HIDB + (size_t)(T_ + 256) * 512 * 2 <= SC_UG, "MoE scratch must stay clear of PROJ");
constexpr size_t WS_END = WS_SCR + SC_END;
constexpr size_t WS_PROJ = WS_SCR + SC_UG;
static_assert(SC_GG - SC_UG == (size_t)T_ * D_ * 2 && WS_END <= 1377669792ull, "ws map");

__device__ __forceinline__ float bf2f(bf16 v) { return __uint_as_float(((unsigned)v) << 16); }
__device__ __forceinline__ unsigned f2bf(float f) { unsigned u = __float_as_uint(f); return (u + 0x7fffu + ((u >> 16) & 1u)) >> 16; }
__device__ __forceinline__ unsigned pk2(float lo, float hi) { return f2bf(lo) | (f2bf(hi) << 16); }
typedef float f32x2_t __attribute__((ext_vector_type(2)));
typedef __bf16 bf16x2_t __attribute__((ext_vector_type(2)));
__device__ __forceinline__ unsigned cvt_pk_bf16(float lo, float hi) { const f32x2_t v = {lo, hi}; const bf16x2_t b = __builtin_convertvector(v, bf16x2_t); return __builtin_bit_cast(unsigned, b); }
__device__ __forceinline__ float silu_f(float x) { return x / (1.f + __expf(-x)); }
__device__ __forceinline__ float wave_sum(float v) {
#pragma unroll
    for (int o = 1; o < 64; o <<= 1) v += __shfl_xor(v, o);
    return v;
}
__device__ __forceinline__ int lane_opaque() { int l; asm volatile("v_mbcnt_lo_u32_b32 %0, -1, 0\n\tv_mbcnt_hi_u32_b32 %0, -1, %0" : "=v"(l)); return l; }
__device__ __forceinline__ float row_rs(const float* ssp, int row) {
    float s = 0.f;
#pragma unroll
    for (int p = 0; p < 8; ++p) s += ssp[(size_t)p * T_ + row];
    return rsqrtf(s * (1.0f / D_) + EPS);
}
__device__ __forceinline__ float sx16(float v) { return __int_as_float(__builtin_amdgcn_ds_swizzle(__float_as_int(v), 0x401F)); }
__device__ __forceinline__ float sx32(float v, int lane) { return __int_as_float(__builtin_amdgcn_ds_bpermute((lane ^ 32) << 2, __float_as_int(v))); }
__device__ __forceinline__ void bf8_to_f32(const u32x4& w, f32x4& lo, f32x4& hi) {
    lo = (f32x4){__uint_as_float(w.x << 16), __uint_as_float(w.x & 0xffff0000u), __uint_as_float(w.y << 16), __uint_as_float(w.y & 0xffff0000u)};
    hi = (f32x4){__uint_as_float(w.z << 16), __uint_as_float(w.z & 0xffff0000u), __uint_as_float(w.w << 16), __uint_as_float(w.w & 0xffff0000u)}; }
#define LDS_WAIT() asm volatile("s_waitcnt lgkmcnt(0)" ::: "memory")
#define VM_WAIT() asm volatile("s_waitcnt vmcnt(0)" ::: "memory")

namespace pg8 {
constexpr int BM = 256, BK = 64, HALF = 128, HTB = HALF * BK * 2, STAGE_BYTES = 8 * HTB, NXCD = 8, WGM = 8;
__host__ __device__ __forceinline__ int lds_byte(int r, int c) { const int st = (r >> 4) * 2 + (c >> 5), rr = r & 15, cc = c & 31, ob = rr * 64 + cc * 2; return st * 1024 + (ob ^ (((ob >> 9) & 1) << 5)); }
__host__ __device__ __forceinline__ void stage_rc(int b, int& R, int& C) { const int st = b / 1024, sb = b % 1024, swz = sb ^ (((sb >> 9) & 1) << 5); R = (st >> 1) * 16 + swz / 64; C = (st & 1) * 32 + (swz % 64) / 2; }
__host__ __device__ __forceinline__ int perm32(int rho) { const int n = rho >> 4, i = rho & 15; return 8 * (i >> 2) + 4 * n + (i & 3); }

struct Unit { int pm, pn, x0, x1, x2; };

struct DenseOrder {
    int nM, nN, nwg, G, c; const char* A; const char* Bt; size_t astep, bstep;
    __device__ void init(const void* A_, const void* Bt_, int M, int N, int lda, int ldb, int G_, int c_) { A = (const char*)A_; Bt = (const char*)Bt_; nM = M / BM; nN = N / BM; nwg = nM * nN; G = G_; c = c_; astep = (size_t)BM * lda * 2; bstep = (size_t)BM * ldb * 2; }
    __device__ bool next(int i, Unit& u) const {
        const long L = (long)i * G + c; if (L >= nwg) return false;
        int wgid = (int)L; { const int q = nwg / NXCD, r = nwg % NXCD, xcd = wgid % NXCD, off = wgid / NXCD; wgid = (xcd < r ? xcd * (q + 1) : r * (q + 1) + (xcd - r) * q) + off; }
        const int nig = WGM * nN, gid = wgid / nig, fm = gid * WGM, gsz = (nM - fm) < WGM ? (nM - fm) : WGM;
        u.pm = fm + ((wgid % nig) % gsz); u.pn = (wgid % nig) / gsz; u.x0 = 0; u.x1 = 0; u.x2 = 0; return true;
    }
    __device__ __forceinline__ const char* a_ptr(const Unit& u) const { return A + (size_t)u.pm * astep; }
    __device__ __forceinline__ const char* b_ptr(const Unit& u, int t) const { return Bt + (size_t)u.pn * bstep + (size_t)t * (BK * 2); }
    __device__ __forceinline__ int a_row(const Unit&, int) const { return 0; }
    __device__ __forceinline__ void a_ready(const Unit&) const {}
    __device__ __forceinline__ void done(const Unit&) const {}
};

template <class Epi, class Sched, bool GATHER, bool ALIGN_EPI>
__device__ __forceinline__ void gemm_phase(LAS unsigned char* lds, const int wave_s, const int K, const int lda, const int ldb, const Sched& S, const Epi& E) {
    const int lane = lane_opaque();
    int wv_ = wave_s; asm volatile("" : "+s"(wv_));
    const int wid = __builtin_amdgcn_readfirstlane(wv_), tid = wid * 64 + lane, wr = wid >> 2, wc = wid & 3, fr = lane & 15, fq = lane >> 4;
    const int nt = K / BK;
    unsigned voffA[2], voffB[2]; int Rr[2], Cc[2];
#pragma unroll
    for (int i = 0; i < 2; ++i) { int R, C; stage_rc(tid * 16 + i * 8192, R, C); const int Rb = (R & ~31) + perm32(R & 31);
        Rr[i] = R; Cc[i] = C; voffA[i] = (unsigned)(R * lda + C) * 2u; voffB[i] = (unsigned)(Rb * ldb + C) * 2u; }
    const size_t kstep = (size_t)(BK * 2);
    const size_t hstepA = (size_t)HALF * lda * 2, hstepB = (size_t)HALF * ldb * 2;
    const unsigned ldsw = (unsigned)wid * 1024u;
    const int aoff = lds_byte(wr * 64 + fr, fq * 8), boff = lds_byte(wc * 32 + fr, fq * 8);
#define PG8_SA(b, h) (((b) * 2 + (h)) * HTB)
#define PG8_SB(b, h) ((4 + (b) * 2 + (h)) * HTB)
#define PG8_STAGE(bufoff, gbase, voff) do { _Pragma("unroll") for (int _i = 0; _i < 2; ++_i) \
        __builtin_amdgcn_global_load_lds((const unsigned*)((const char*)(gbase) + (voff)[_i]), (LAS unsigned*)(lds + (bufoff) + ldsw + _i * 8192), 16, 0, 0); } while (0)
#define PG8_STAGE_A(bufoff, gbase, h, vo) do { if constexpr (GATHER) { PG8_STAGE(bufoff, gbase, (vo)[h]); } else { PG8_STAGE(bufoff, (gbase) + (h) * hstepA, voffA); } } while (0)
#define PG8_STAGE_B(bufoff, gbase, h) PG8_STAGE(bufoff, (gbase) + (h) * hstepB, voffB)
#define PG8_LDA(dst, b, h) do { _Pragma("unroll") for (int m = 0; m < 4; ++m) _Pragma("unroll") for (int k = 0; k < 2; ++k) dst[m][k] = *(const LAS bf16x8*)(lds + PG8_SA(b, h) + aoff + m * 2048 + k * 1024); } while (0)
#define PG8_LDB(dst, b, h) do { _Pragma("unroll") for (int n = 0; n < 2; ++n) _Pragma("unroll") for (int k = 0; k < 2; ++k) dst[n][k] = *(const LAS bf16x8*)(lds + PG8_SB(b, h) + boff + n * 2048 + k * 1024); } while (0)
#define PG8_MMA(ai, bj, At, Bt) do { __builtin_amdgcn_s_setprio(1); _Pragma("unroll") for (int m = 0; m < 4; ++m) _Pragma("unroll") for (int n = 0; n < 2; ++n) _Pragma("unroll") for (int k = 0; k < 2; ++k) \
        acc[ai][bj][m][n] = __builtin_amdgcn_mfma_f32_16x16x32_bf16(Bt[n][k], At[m][k], acc[ai][bj][m][n], 0, 0, 0); __builtin_amdgcn_s_setprio(0); } while (0)
#define PG8_WAIT_V(n) asm volatile("s_waitcnt vmcnt(" #n ")" ::: "memory")
#define PG8_WAIT_L(n) asm volatile("s_waitcnt lgkmcnt(" #n ")" ::: "memory")
#define PG8_BAR __builtin_amdgcn_s_barrier()
#define PG8_SCHED __builtin_amdgcn_sched_barrier(0)
    Unit cur, nxt; int ui = 0;
    if (!S.next(0, cur)) return;
    f32x4 acc[2][2][4][2];
#pragma unroll
    for (int a = 0; a < 2; ++a)
#pragma unroll
        for (int b = 0; b < 2; ++b)
#pragma unroll
            for (int m = 0; m < 4; ++m)
#pragma unroll
                for (int n = 0; n < 2; ++n) acc[a][b][m][n] = (f32x4){0.f, 0.f, 0.f, 0.f};
    bf16x8 At[4][2], B0[2][2], B1[2][2];
    unsigned voC[2][2] = {{0u, 0u}, {0u, 0u}}, voN[2][2] = {{0u, 0u}, {0u, 0u}};
    const char* cA = S.a_ptr(cur);
    if constexpr (GATHER) {
#pragma unroll
        for (int h = 0; h < 2; ++h)
#pragma unroll
            for (int i = 0; i < 2; ++i) voC[h][i] = (unsigned)(S.a_row(cur, h * HALF + Rr[i]) * lda + Cc[i]) * 2u;
    }
    S.a_ready(cur);
    {   const char* b0p = S.b_ptr(cur, 0); const char* b1p = S.b_ptr(cur, 1);
        PG8_STAGE_B(PG8_SB(0, 0), b0p, 0); PG8_STAGE_B(PG8_SB(0, 1), b0p, 1); PG8_STAGE_A(PG8_SA(0, 0), cA, 0, voC); PG8_STAGE_A(PG8_SA(0, 1), cA, 1, voC);
        if (wr == 1) PG8_BAR;
        PG8_WAIT_V(2); PG8_BAR;
        PG8_STAGE_B(PG8_SB(1, 0), b1p, 0); PG8_STAGE_A(PG8_SA(1, 0), cA + kstep, 0, voC); PG8_STAGE_B(PG8_SB(1, 1), b1p, 1);
        PG8_WAIT_V(6); PG8_BAR; }
    for (;;) {
        const bool has_next = S.next(ui + 1, nxt);
        const char* nA = has_next ? S.a_ptr(nxt) : cA;
        for (int t = 0; t < nt; t += 2) {
            const bool last = (t == nt - 2);
            const char* a1 = cA + (size_t)(t + 1) * kstep;
            const char* a2 = last ? nA : cA + (size_t)(t + 2) * kstep; const char* a3 = a2 + kstep;
            const char* b2 = last ? (has_next ? S.b_ptr(nxt, 0) : S.b_ptr(cur, 0)) : S.b_ptr(cur, t + 2);
            const char* b3 = last ? (has_next ? S.b_ptr(nxt, 1) : S.b_ptr(cur, 1)) : S.b_ptr(cur, t + 3);
            unsigned vo2[2][2];
            if (last && has_next) { S.a_ready(nxt);
                if constexpr (GATHER) {
#pragma unroll
                    for (int h = 0; h < 2; ++h)
#pragma unroll
                        for (int i = 0; i < 2; ++i) voN[h][i] = (unsigned)(S.a_row(nxt, h * HALF + Rr[i]) * lda + Cc[i]) * 2u;
                } }
#pragma unroll
            for (int h = 0; h < 2; ++h)
#pragma unroll
                for (int i = 0; i < 2; ++i) vo2[h][i] = (last && has_next) ? voN[h][i] : voC[h][i];
            PG8_LDB(B0, 0, 0); PG8_LDB(B1, 0, 1); PG8_SCHED; PG8_LDA(At, 0, 0); PG8_STAGE_A(PG8_SA(1, 1), a1, 1, voC);
            PG8_WAIT_V(8); PG8_WAIT_L(0); PG8_BAR; PG8_MMA(0, 0, At, B0); PG8_MMA(0, 1, At, B1); PG8_BAR; PG8_SCHED;
            PG8_LDA(At, 0, 1); PG8_STAGE_B(PG8_SB(0, 0), b2, 0); PG8_STAGE_B(PG8_SB(0, 1), b2, 1); PG8_STAGE_A(PG8_SA(0, 0), a2, 0, vo2);
            PG8_WAIT_V(8); PG8_WAIT_L(0); PG8_BAR; PG8_MMA(1, 0, At, B0); PG8_MMA(1, 1, At, B1); PG8_BAR; PG8_SCHED;
            PG8_LDB(B0, 1, 0); PG8_LDB(B1, 1, 1); PG8_SCHED; PG8_LDA(At, 1, 0); PG8_STAGE_A(PG8_SA(0, 1), a2, 1, vo2);
            PG8_WAIT_V(8); PG8_WAIT_L(0); PG8_BAR; PG8_MMA(0, 0, At, B0); PG8_MMA(0, 1, At, B1); PG8_BAR; PG8_SCHED;
            PG8_LDA(At, 1, 1); PG8_STAGE_B(PG8_SB(1, 0), b3, 0); PG8_STAGE_B(PG8_SB(1, 1), b3, 1); PG8_STAGE_A(PG8_SA(1, 0), a3, 0, vo2);
            PG8_WAIT_V(8); PG8_WAIT_L(0); PG8_BAR; PG8_MMA(1, 0, At, B0); PG8_MMA(1, 1, At, B1); PG8_BAR; PG8_SCHED;
        }
        if constexpr (ALIGN_EPI) { if (wr == 0) PG8_BAR; }
        { const int le = lane_opaque(); E(acc, cur, wr, wc, le & 15, le >> 4); } S.done(cur);
        if (!has_next) break;
#pragma unroll
        for (int a = 0; a < 2; ++a)
#pragma unroll
            for (int b = 0; b < 2; ++b)
#pragma unroll
                for (int m = 0; m < 4; ++m)
#pragma unroll
                    for (int n = 0; n < 2; ++n) acc[a][b][m][n] = (f32x4){0.f, 0.f, 0.f, 0.f};
        cur = nxt; cA = nA; ++ui;
        if constexpr (GATHER) {
#pragma unroll
            for (int h = 0; h < 2; ++h)
#pragma unroll
                for (int i = 0; i < 2; ++i) voC[h][i] = voN[h][i];
        }
        if constexpr (ALIGN_EPI) { if (wr == 1) PG8_BAR; }
    }
    PG8_WAIT_V(0);
    if constexpr (!ALIGN_EPI) { if (wr == 0) PG8_BAR; }
    PG8_BAR;
#undef PG8_SA
#undef PG8_SB
#undef PG8_STAGE
#undef PG8_STAGE_A
#undef PG8_STAGE_B
#undef PG8_LDA
#undef PG8_LDB
#undef PG8_MMA
#undef PG8_WAIT_V
#undef PG8_WAIT_L
#undef PG8_BAR
#undef PG8_SCHED
}

struct EpiZ {
    bf16* O; const float* ss; const float* ROT;
    __device__ __forceinline__ void operator()(const f32x4 (&acc)[2][2][4][2], const Unit& u, int wr, int wc, int fr, int fq) const {
        const int row0 = u.pm * BM + wr * 64 + fr, col0 = u.pn * BM + wc * 32 + 8 * fq;
        const bool rot = u.pn < 6; const float ksc = (u.pn >= 3) ? 0.08838834764831845f : 1.0f;
#pragma unroll
        for (int ai = 0; ai < 2; ++ai)
#pragma unroll
            for (int m = 0; m < 4; ++m) { const int row = row0 + ai * HALF + m * 16; const float rs = row_rs(ss, row);
                bf16* rowp = O + (size_t)row * ZLD + col0;
                f32x4 cs = {1.f, 1.f, 1.f, 1.f}, sn = {0.f, 0.f, 0.f, 0.f};
                if (rot) { const float* cp = ROT + (size_t)(row & (S_ - 1)) * 64 + 16 * wc + 4 * fq; cs = *(const f32x4*)cp * ksc; sn = *(const f32x4*)(cp + (size_t)S_ * 64) * ksc; }
#pragma unroll
                for (int bj = 0; bj < 2; ++bj) { const f32x4 a0 = acc[ai][bj][m][0] * rs, a1 = acc[ai][bj][m][1] * rs;
                    const f32x4 v0 = a0 * cs - a1 * sn, v1 = a0 * sn + a1 * cs;
                    u32x4 w; w.x = cvt_pk_bf16(v0[0], v0[1]); w.y = cvt_pk_bf16(v0[2], v0[3]); w.z = cvt_pk_bf16(v1[0], v1[1]); w.w = cvt_pk_bf16(v1[2], v1[3]);
                    *(u32x4*)(rowp + bj * HALF) = w; } }
    }
};
struct EpiB {
    bf16* O; int ldc;
    __device__ __forceinline__ void operator()(const f32x4 (&acc)[2][2][4][2], const Unit& u, int wr, int wc, int fr, int fq) const {
        const int row0 = u.pm * BM + wr * 64 + fr, col0 = u.pn * BM + wc * 32 + 8 * fq;
#pragma unroll
        for (int ai = 0; ai < 2; ++ai)
#pragma unroll
            for (int m = 0; m < 4; ++m) { bf16* rowp = O + (size_t)(row0 + ai * HALF + m * 16) * ldc + col0;
#pragma unroll
                for (int bj = 0; bj < 2; ++bj) { const f32x4 v0 = acc[ai][bj][m][0], v1 = acc[ai][bj][m][1];
                    u32x4 w; w.x = cvt_pk_bf16(v0[0], v0[1]); w.y = cvt_pk_bf16(v0[2], v0[3]); w.z = cvt_pk_bf16(v1[0], v1[1]); w.w = cvt_pk_bf16(v1[2], v1[3]);
                    *(u32x4*)(rowp + bj * HALF) = w; } }
    }
};
__device__ __forceinline__ void ss_finish(LAS float* red, float* ssn, const Unit& u, int wr, int wc, int fr) {
    asm volatile("s_waitcnt lgkmcnt(0)" ::: "memory"); __builtin_amdgcn_s_barrier(); asm volatile("" ::: "memory");
    const int t = (wr * 4 + wc) * 64 + lane_opaque();
    if (t < 256) { const float v = ((red[t] + red[256 + t]) + red[512 + t]) + red[768 + t]; ssn[(size_t)u.pn * T_ + u.pm * BM + t] = v; }
    (void)fr;
}
struct EpiRes {
    const bf16* XI; bf16* XO; float* ssn; LAS float* red;
    __device__ __forceinline__ void operator()(const f32x4 (&acc)[2][2][4][2], const Unit& u, int wr, int wc, int fr, int fq) const {
        const int row0 = u.pm * BM + wr * 64 + fr, col0 = u.pn * BM + wc * 32 + 8 * fq;
#pragma unroll
        for (int ai = 0; ai < 2; ++ai)
#pragma unroll
            for (int m = 0; m < 4; ++m) { const int row = row0 + ai * HALF + m * 16; const bf16* xi = XI + (size_t)row * D_ + col0; bf16* xo = XO + (size_t)row * D_ + col0; float s = 0.f;
#pragma unroll
                for (int bj = 0; bj < 2; ++bj) { f32x4 x0, x1; bf8_to_f32(*(const u32x4*)(xi + bj * HALF), x0, x1);
                    const f32x4 v0 = acc[ai][bj][m][0] + x0, v1 = acc[ai][bj][m][1] + x1;
                    s += (v0[0] * v0[0] + v0[1] * v0[1]) + (v0[2] * v0[2] + v0[3] * v0[3]) + (v1[0] * v1[0] + v1[1] * v1[1]) + (v1[2] * v1[2] + v1[3] * v1[3]);
                    u32x4 w; w.x = cvt_pk_bf16(v0[0], v0[1]); w.y = cvt_pk_bf16(v0[2], v0[3]); w.z = cvt_pk_bf16(v1[0], v1[1]); w.w = cvt_pk_bf16(v1[2], v1[3]);
                    *(u32x4*)(xo + bj * HALF) = w; }
                s += sx16(s); s += sx32(s, fq * 16 + fr);
                if (fq == 0) red[wc * 256 + ai * HALF + wr * 64 + m * 16 + fr] = s; }
        ss_finish(red, ssn, u, wr, wc, fr);
    }
};
struct EpiPle {
    const bf16* XI; bf16* XO; const bf16* PR; const float* ss; float* ssn; LAS float* red;
    __device__ __forceinline__ void operator()(const f32x4 (&acc)[2][2][4][2], const Unit& u, int wr, int wc, int fr, int fq) const {
        const int row0 = u.pm * BM + wr * 64 + fr, col0 = u.pn * BM + wc * 32 + 8 * fq;
#pragma unroll
        for (int ai = 0; ai < 2; ++ai)
#pragma unroll
            for (int m = 0; m < 4; ++m) { const int row = row0 + ai * HALF + m * 16; const bf16* xi = XI + (size_t)row * D_ + col0; bf16* xo = XO + (size_t)row * D_ + col0; const bf16* pr = PR + (size_t)row * D_ + col0;
                const float rs = row_rs(ss, row); float s = 0.f;
#pragma unroll
                for (int bj = 0; bj < 2; ++bj) { f32x4 p0, p1, v0, v1; bf8_to_f32(*(const u32x4*)(pr + bj * HALF), p0, p1); bf8_to_f32(*(const u32x4*)(xi + bj * HALF), v0, v1);
#pragma unroll
                    for (int j = 0; j < 4; ++j) { v0[j] += p0[j] / (1.f + __expf(-rs * acc[ai][bj][m][0][j])); v1[j] += p1[j] / (1.f + __expf(-rs * acc[ai][bj][m][1][j])); }
                    s += (v0[0] * v0[0] + v0[1] * v0[1]) + (v0[2] * v0[2] + v0[3] * v0[3]) + (v1[0] * v1[0] + v1[1] * v1[1]) + (v1[2] * v1[2] + v1[3] * v1[3]);
                    u32x4 w; w.x = cvt_pk_bf16(v0[0], v0[1]); w.y = cvt_pk_bf16(v0[2], v0[3]); w.z = cvt_pk_bf16(v1[0], v1[1]); w.w = cvt_pk_bf16(v1[2], v1[3]);
                    *(u32x4*)(xo + bj * HALF) = w; }
                s += sx16(s); s += sx32(s, fq * 16 + fr);
                if (fq == 0) red[wc * 256 + ai * HALF + wr * 64 + m * 16 + fr] = s; }
        ss_finish(red, ssn, u, wr, wc, fr);
    }
};

constexpr int MT_TILE = 8, MT_R0 = 200, MT_POS = 392, MT_CNT = 600, MT_MAXT = 190;
__device__ __forceinline__ void moe_build_table(LAS int* tb, const unsigned* cnt, int tidx) {
    if (tidx < 112) tb[MT_CNT + tidx] = (int)__hip_atomic_load(cnt + tidx, __ATOMIC_RELAXED, __HIP_MEMORY_SCOPE_AGENT);
    __syncthreads();
    if (tidx == 0) { int nt = 0, pos = 0;
        for (int b = 0; b < 112; ++b) { const int n = tb[MT_CNT + b]; const int g = b / 28; int p = b % 28, a = 0; while (p >= 7 - a) { p -= 7 - a; ++a; } const int eb = a + 1 + p;
            for (int r0 = 0; r0 < n && nt < MT_MAXT; r0 += 256) { const int nv = (n - r0) < 256 ? (n - r0) : 256;
                tb[MT_TILE + nt] = b | ((g * 8 + a) << 8) | ((g * 8 + eb) << 16); tb[MT_R0 + nt] = r0 | (nv << 16); tb[MT_POS + nt] = pos + r0; ++nt; }
            pos += n; }
        tb[0] = nt; }
    __syncthreads();
}
struct MoeOrder1 {
    LAS int* tb; const char* XB; const char* Wgu; const u32x4* ent; int G, c;
    __device__ bool next(int i, Unit& u) const { const int n = i * G + c; const int NT = __builtin_amdgcn_readfirstlane(tb[0]); if (n >= NT * 4) return false; const int t = n >> 2;
        u.pm = t; u.pn = n & 3; u.x0 = __builtin_amdgcn_readfirstlane(tb[MT_TILE + t]); u.x1 = __builtin_amdgcn_readfirstlane(tb[MT_R0 + t]); u.x2 = __builtin_amdgcn_readfirstlane(tb[MT_POS + t]); return true; }
    __device__ __forceinline__ const char* a_ptr(const Unit&) const { return XB; }
    __device__ __forceinline__ const char* b_ptr(const Unit& u, int t) const { const int ge = (u.pn < 2) ? ((u.x0 >> 8) & 255) : ((u.x0 >> 16) & 255);
        return Wgu + ((size_t)ge * 512 + (size_t)(u.pn & 1) * 256) * (D_ * 2) + (size_t)t * (BK * 2); }
    __device__ __forceinline__ int a_row(const Unit& u, int r) const { const int nv = u.x1 >> 16; const int r0 = u.x1 & 0xffff;
        return (int)ent[(size_t)(u.x0 & 255) * T_ + r0 + (r < nv ? r : 0)].x; }
    __device__ __forceinline__ void a_ready(const Unit&) const {}
    __device__ __forceinline__ void done(const Unit&) const {}
};
struct MoeOrder2 {
    LAS int* tb; const char* HID; const char* Wd; int G, c;
    __device__ bool next(int i, Unit& u) const { const int n = i * G + c; const int NT = __builtin_amdgcn_readfirstlane(tb[0]); if (n >= NT * 8) return false; const int t = n >> 3;
        u.pm = t; u.pn = n & 7; u.x0 = __builtin_amdgcn_readfirstlane(tb[MT_TILE + t]); u.x1 = __builtin_amdgcn_readfirstlane(tb[MT_R0 + t]); u.x2 = __builtin_amdgcn_readfirstlane(tb[MT_POS + t]); return true; }
    __device__ __forceinline__ const char* a_ptr(const Unit& u) const { return HID + (size_t)u.x2 * (512 * 2); }
    __device__ __forceinline__ const char* b_ptr(const Unit& u, int t) const { const int ge = (t < 4) ? ((u.x0 >> 8) & 255) : ((u.x0 >> 16) & 255);
        return Wd + (size_t)(ge >> 3) * ((size_t)D_ * D_ * 2) + (size_t)u.pn * 256 * (D_ * 2) + (size_t)((ge & 7) * 256 + (t & 3) * BK) * 2; }
    __device__ __forceinline__ int a_row(const Unit&, int) const { return 0; }
    __device__ __forceinline__ void a_ready(const Unit&) const {}
    __device__ __forceinline__ void done(const Unit&) const {}
};
struct EpiHid {
    bf16* HID; const u32x4* ent;
    __device__ __forceinline__ void operator()(const f32x4 (&acc)[2][2][4][2], const Unit& u, int wr, int wc, int fr, int fq) const {
        const int nv = u.x1 >> 16, r0 = u.x1 & 0xffff; const u32x4* eb = ent + (size_t)(u.x0 & 255) * T_ + r0;
        const int colo = (u.pn >> 1) * 256 + (u.pn & 1) * 128 + wc * 32 + 8 * fq;
#pragma unroll
        for (int ai = 0; ai < 2; ++ai)
#pragma unroll
            for (int m = 0; m < 4; ++m) { const int r = ai * HALF + wr * 64 + m * 16 + fr;
                if (r < nv) { const u32x4 e = eb[r]; const float rs = __uint_as_float(e.w), cw = __uint_as_float(u.pn < 2 ? e.y : e.z);
                    float h[8];
#pragma unroll
                    for (int n = 0; n < 2; ++n)
#pragma unroll
                        for (int j = 0; j < 4; ++j) { const float a = rs * acc[ai][0][m][n][j], up = rs * acc[ai][1][m][n][j]; h[n * 4 + j] = a / (1.f + __expf(-a)) * up * cw; }
                    u32x4 w; w.x = cvt_pk_bf16(h[0], h[1]); w.y = cvt_pk_bf16(h[2], h[3]); w.z = cvt_pk_bf16(h[4], h[5]); w.w = cvt_pk_bf16(h[6], h[7]);
                    *(u32x4*)(HID + (size_t)(u.x2 + r) * 512 + colo) = w; } }
    }
};
struct EpiMoe2 {
    const bf16* XI; bf16* XO; float* ssn; const u32x4* ent; LAS float* red;
    __device__ __forceinline__ void operator()(const f32x4 (&acc)[2][2][4][2], const Unit& u, int wr, int wc, int fr, int fq) const {
        const int nv = u.x1 >> 16, r0 = u.x1 & 0xffff; const u32x4* eb = ent + (size_t)(u.x0 & 255) * T_ + r0;
        const int col0 = u.pn * BM + wc * 32 + 8 * fq;
#pragma unroll
        for (int ai = 0; ai < 2; ++ai)
#pragma unroll
            for (int m = 0; m < 4; ++m) { const int r = ai * HALF + wr * 64 + m * 16 + fr; float s = 0.f;
                if (r < nv) { const int tok = (int)eb[r].x; const bf16* xi = XI + (size_t)tok * D_ + col0; bf16* xo = XO + (size_t)tok * D_ + col0;
#pragma unroll
                    for (int bj = 0; bj < 2; ++bj) { f32x4 x0, x1; bf8_to_f32(*(const u32x4*)(xi + bj * HALF), x0, x1);
                        const f32x4 v0 = acc[ai][bj][m][0] + x0, v1 = acc[ai][bj][m][1] + x1;
                        s += (v0[0] * v0[0] + v0[1] * v0[1]) + (v0[2] * v0[2] + v0[3] * v0[3]) + (v1[0] * v1[0] + v1[1] * v1[1]) + (v1[2] * v1[2] + v1[3] * v1[3]);
                        u32x4 w; w.x = cvt_pk_bf16(v0[0], v0[1]); w.y = cvt_pk_bf16(v0[2], v0[3]); w.z = cvt_pk_bf16(v1[0], v1[1]); w.w = cvt_pk_bf16(v1[2], v1[3]);
                        *(u32x4*)(xo + bj * HALF) = w; } }
                s += sx16(s); s += sx32(s, fq * 16 + fr);
                if (fq == 0) red[wc * 256 + r] = s; }
        asm volatile("s_waitcnt lgkmcnt(0)" ::: "memory"); __builtin_amdgcn_s_barrier(); asm volatile("" ::: "memory");
        const int t = (wr * 4 + wc) * 64 + lane_opaque();
        if (t < nv) { const float v = ((red[t] + red[256 + t]) + red[512 + t]) + red[768 + t]; ssn[(size_t)u.pn * T_ + (int)eb[t].x] = v; }
    }
};
}


namespace mx {
typedef short s16x4 __attribute__((ext_vector_type(4)));
typedef short v4i16_t __attribute__((ext_vector_type(4)));
#define MFMA16(a, b, c) __builtin_amdgcn_mfma_f32_16x16x32_bf16((a), (b), (c), 0, 0, 0)
__device__ __forceinline__ bf16x8 frag_row(const LAS unsigned char* T, int P, int row0, int col0, int lane) { return *(const LAS bf16x8*)(T + (row0 + (lane & 15)) * P + (col0 + 8 * (lane >> 4)) * 2); }
__device__ __forceinline__ s16x4 ld_tr(const LAS unsigned char* p) { return __builtin_bit_cast(s16x4, __builtin_amdgcn_ds_read_tr16_b64_v4i16((LAS v4i16_t*)p)); }
__device__ __forceinline__ bf16x8 frag_tr(const LAS unsigned char* T, int P, int rowA, int rowB, int col0, int lane) {
    const int q = (lane & 15) >> 2, p = lane & 3;
    const s16x4 a = ld_tr(T + (rowA + q) * P + (col0 + 4 * p) * 2), b = ld_tr(T + (rowB + q) * P + (col0 + 4 * p) * 2);
    return (bf16x8){a[0], a[1], a[2], a[3], b[0], b[1], b[2], b[3]};
}
__device__ __forceinline__ bf16x8 pack8(const f32x4& a, const f32x4& b) { u32x4 w; w.x = cvt_pk_bf16(a[0], a[1]); w.y = cvt_pk_bf16(a[2], a[3]); w.z = cvt_pk_bf16(b[0], b[1]); w.w = cvt_pk_bf16(b[2], b[3]); return __builtin_bit_cast(bf16x8, w); }
constexpr int P128 = 272, P64 = 144;
constexpr int T64x128 = 64 * P128;

__device__ __forceinline__ void attn_items(LAS unsigned char* lds, const bf16* __restrict__ Z, const float* __restrict__ relb, bf16* __restrict__ Y, int G, int bx, int wave, int lane) {
    LAS unsigned char* Kb = lds; LAS unsigned char* Vb = lds + 2 * T64x128; LAS float* bs = (LAS float*)(lds + 4 * T64x128);
    const int i = lane & 15, g = lane >> 4, tid = wave * 64 + lane, grp = wave >> 2;
    for (int item = bx; item < B_ * ATT_H * (NCH / 2); item += G) {
        const int np = item & 63, bh = item >> 6, h = bh % ATT_H, b = bh / ATT_H, nA = 2 * np;
        const size_t tok0 = (size_t)b * S_ + (size_t)(nA + grp) * CH + 16 * (wave & 3);
        bf16x8 qf[4];
#pragma unroll
        for (int s = 0; s < 4; ++s) qf[s] = *(const bf16x8*)(Z + (tok0 + i) * ZLD + O_AQ + h * HD + 32 * s + 8 * g);
        for (int t = tid; t < 257; t += NTHR) bs[t] = relb[h * 257 + t];
        const int j0 = (nA < 8) ? (8 - nA) : 0;
        u32x4 kr[2], vr[2];
#define ATT_GLOAD(j) do { const size_t rb_ = (size_t)b * S_ + (size_t)(nA - 8 + (j)) * CH; _Pragma("unroll") for (int u_ = 0; u_ < 2; ++u_) { const int c_ = tid + NTHR * u_; \
            const bf16* zp_ = Z + (rb_ + (c_ >> 4)) * ZLD + h * HD + (c_ & 15) * 8; kr[u_] = *(const u32x4*)(zp_ + O_AK); vr[u_] = *(const u32x4*)(zp_ + O_AV); } } while (0)
#define ATT_LSTORE(buf) do { _Pragma("unroll") for (int u_ = 0; u_ < 2; ++u_) { const int c_ = tid + NTHR * u_; const int o_ = (buf) * T64x128 + (c_ >> 4) * P128 + (c_ & 15) * 16; \
            *(LAS u32x4*)(Kb + o_) = kr[u_]; *(LAS u32x4*)(Vb + o_) = vr[u_]; } } while (0)
        ATT_GLOAD(j0); ATT_LSTORE(j0 & 1);
        __syncthreads();
        float m_run = -3.0e38f, l_run = 0.f;
        f32x4 o[8];
#pragma unroll
        for (int dt = 0; dt < 8; ++dt) o[dt] = (f32x4){0.f, 0.f, 0.f, 0.f};
        const int cq = 16 * (wave & 3) + i;
        float qscale = 0.08838834764831845f; asm volatile("" : "+v"(qscale));
        for (int j = j0; j < 10; ++j) {
            if (j + 1 < 10) ATT_GLOAD(j + 1);
            const int jt = j - grp;
            if (jt >= 0 && jt <= 8) {
                const LAS unsigned char* Kt = Kb + (j & 1) * T64x128; const LAS unsigned char* Vt = Vb + (j & 1) * T64x128;
                f32x4 sc[4];
#pragma unroll
                for (int mt = 0; mt < 4; ++mt) { sc[mt] = (f32x4){0.f, 0.f, 0.f, 0.f};
#pragma unroll
                    for (int s = 0; s < 4; ++s) sc[mt] = MFMA16(frag_row(Kt, P128, 16 * mt, 32 * s, lane), qf[s], sc[mt]); }
                float mxv = -3.0e38f;
                if (jt <= 5) { const float bb = bs[256];
#pragma unroll
                    for (int mt = 0; mt < 4; ++mt)
#pragma unroll
                        for (int r = 0; r < 4; ++r) { sc[mt][r] = sc[mt][r] * qscale + bb; mxv = fmaxf(mxv, sc[mt][r]); }
                } else {
#pragma unroll
                    for (int mt = 0; mt < 4; ++mt)
#pragma unroll
                        for (int r = 0; r < 4; ++r) { int rel = 512 + cq - 64 * jt - (16 * mt + 4 * g + r); rel = rel > 128 ? 128 : rel;
                            sc[mt][r] = sc[mt][r] * qscale + bs[rel + 128]; mxv = fmaxf(mxv, sc[mt][r]); }
                }
                mxv = fmaxf(mxv, sx16(mxv)); mxv = fmaxf(mxv, sx32(mxv, lane));
                const float m_new = fmaxf(m_run, mxv), alpha = __expf(m_run - m_new); m_run = m_new;
                float ls = 0.f;
#pragma unroll
                for (int mt = 0; mt < 4; ++mt)
#pragma unroll
                    for (int r = 0; r < 4; ++r) { sc[mt][r] = __expf(sc[mt][r] - m_new); ls += sc[mt][r]; }
                l_run = l_run * alpha + ls;
#pragma unroll
                for (int dt = 0; dt < 8; ++dt) o[dt] = o[dt] * alpha;
#pragma unroll
                for (int ks = 0; ks < 2; ++ks) { const bf16x8 pf = pack8(sc[2 * ks], sc[2 * ks + 1]);
#pragma unroll
                    for (int dt = 0; dt < 8; ++dt) o[dt] = MFMA16(frag_tr(Vt, P128, 32 * ks + 4 * g, 32 * ks + 16 + 4 * g, 16 * dt, lane), pf, o[dt]); }
            }
            if (j + 1 < 10) ATT_LSTORE((j + 1) & 1);
            __syncthreads();
        }
#undef ATT_GLOAD
#undef ATT_LSTORE
        float lt = l_run; lt += sx16(lt); lt += sx32(lt, lane);
        const float inv = 1.0f / lt; float ssq = 0.f;
#pragma unroll
        for (int dt = 0; dt < 8; ++dt) { o[dt] = o[dt] * inv; ssq += (o[dt][0] * o[dt][0] + o[dt][1] * o[dt][1]) + (o[dt][2] * o[dt][2] + o[dt][3] * o[dt][3]); }
        ssq += sx16(ssq); ssq += sx32(ssq, lane);
        const float rs = rsqrtf(ssq * (1.0f / HD) + EPS);
        bf16* yo = Y + (tok0 + i) * D_ + 1280 + h * HD + 4 * g;
#pragma unroll
        for (int dt = 0; dt < 8; ++dt) { u32x2 w; w.x = cvt_pk_bf16(o[dt][0] * rs, o[dt][1] * rs); w.y = cvt_pk_bf16(o[dt][2] * rs, o[dt][3] * rs); *(u32x2*)(yo + 16 * dt) = w; }
    }
}

__device__ __forceinline__ float lgam(int h) { return logf(1.0f - exp2f(-5.0f - (float)h)); }
__device__ __forceinline__ void unpack8(const u32x4& w, float (&f)[8]) {
    f[0] = __uint_as_float(w.x << 16); f[1] = __uint_as_float(w.x & 0xffff0000u); f[2] = __uint_as_float(w.y << 16); f[3] = __uint_as_float(w.y & 0xffff0000u);
    f[4] = __uint_as_float(w.z << 16); f[5] = __uint_as_float(w.z & 0xffff0000u); f[6] = __uint_as_float(w.w << 16); f[7] = __uint_as_float(w.w & 0xffff0000u); }
__device__ __forceinline__ u32x4 pack8f(const float (&f)[8]) { u32x4 w; w.x = cvt_pk_bf16(f[0], f[1]); w.y = cvt_pk_bf16(f[2], f[3]); w.z = cvt_pk_bf16(f[4], f[5]); w.w = cvt_pk_bf16(f[6], f[7]); return w; }
constexpr int RU_HALF = 2 * T64x128, RO_HALF = 2 * T64x128 + 128 * P128, GU_HALF = 64 * P64 + T64x128 + 4096 + 1024, GO_HALF = 2 * 64 * P64 + 2 * T64x128 + 4096 + 1024;
__device__ __forceinline__ void ret_upd_items(LAS unsigned char* lds, const bf16* __restrict__ Z, bf16* __restrict__ U, int G, int bx, int wave, int lane) {
    const int h2 = wave >> 2, w4 = wave & 3, i = lane & 15, g = lane >> 4, t2 = w4 * 64 + lane;
    LAS unsigned char* Kz = lds + h2 * RU_HALF; LAS unsigned char* Vt = Kz + T64x128;
    for (int p = bx; p < B_ * RET_H * NCH / 2; p += G) {
        const int item = 2 * p + h2, n = item & 127, bh = item >> 7, h = bh % RET_H, b = bh / RET_H; const float lg = lgam(h); const size_t row0 = (size_t)b * S_ + n * CH;
#pragma unroll
        for (int u = 0; u < 4; ++u) { const int c = t2 + 256 * u, row = c >> 4, ch = c & 15; const bf16* zp = Z + (row0 + row) * ZLD + h * HD + ch * 8;
            *(LAS u32x4*)(Kz + row * P128 + ch * 16) = *(const u32x4*)(zp + O_RK);
            float f[8]; unpack8(*(const u32x4*)(zp + O_RV), f); const float zt = __expf(lg * (float)(63 - row));
#pragma unroll
            for (int j = 0; j < 8; ++j) f[j] *= zt;
            *(LAS u32x4*)(Vt + row * P128 + ch * 16) = pack8f(f); }
        __syncthreads();
        f32x4 acc[2][8];
#pragma unroll
        for (int ee = 0; ee < 2; ++ee)
#pragma unroll
            for (int dt = 0; dt < 8; ++dt) acc[ee][dt] = (f32x4){0.f, 0.f, 0.f, 0.f};
#pragma unroll
        for (int ks = 0; ks < 2; ++ks) { const bf16x8 a0 = frag_tr(Vt, P128, 32 * ks + 8 * g, 32 * ks + 8 * g + 4, 16 * (2 * w4), lane), a1 = frag_tr(Vt, P128, 32 * ks + 8 * g, 32 * ks + 8 * g + 4, 16 * (2 * w4 + 1), lane);
#pragma unroll
            for (int dt = 0; dt < 8; ++dt) { const bf16x8 kf = frag_tr(Kz, P128, 32 * ks + 8 * g, 32 * ks + 8 * g + 4, 16 * dt, lane); acc[0][dt] = MFMA16(a0, kf, acc[0][dt]); acc[1][dt] = MFMA16(a1, kf, acc[1][dt]); } }
        bf16* Uo = U + (size_t)item * 16384 + (size_t)i * 128 + 32 * w4 + 4 * g;
#pragma unroll
        for (int ee = 0; ee < 2; ++ee)
#pragma unroll
            for (int dt = 0; dt < 8; ++dt) { u32x2 w; w.x = cvt_pk_bf16(acc[ee][dt][0], acc[ee][dt][1]); w.y = cvt_pk_bf16(acc[ee][dt][2], acc[ee][dt][3]); *(u32x2*)(Uo + (size_t)dt * 16 * 128 + 16 * ee) = w; }
        __syncthreads();
    }
}
__device__ __forceinline__ float gla_decay(LAS float* gaL, LAS float* tot, const bf16* __restrict__ Z, size_t row0, const float* __restrict__ Wa, const float* __restrict__ ba, int h, int t2, float (&bcd)[16]) {
    if (t2 < 128) { float f[8]; unpack8(*(const u32x4*)(Z + (row0 + (t2 >> 1)) * ZLD + O_GA + 8 * (t2 & 1)), f);
#pragma unroll
        for (int j = 0; j < 8; ++j) gaL[(t2 >> 1) * 16 + 8 * (t2 & 1) + j] = f[j]; }
    const int d = t2 & 63, blk = t2 >> 6;
    float w[GRANK];
#pragma unroll
    for (int r = 0; r < GRANK; ++r) w[r] = Wa[r * 256 + h * 64 + d];
    const float bb = ba[h * 64 + d];
    __syncthreads();
    float cum = 0.f;
#pragma unroll
    for (int i16 = 0; i16 < 16; ++i16) { float x = bb;
#pragma unroll
        for (int r = 0; r < GRANK; ++r) x += gaL[(16 * blk + i16) * 16 + r] * w[r];
        const float ls = fminf(x, 0.f) - log1pf(__expf(-fabsf(x)));
        cum += ls * (1.0f / 16.0f); bcd[i16] = cum; }
    tot[blk * 64 + d] = cum;
    __syncthreads();
    float pre = 0.f, blast = 0.f;
#pragma unroll
    for (int b2 = 0; b2 < 4; ++b2) { const float t = tot[b2 * 64 + d]; blast += t; pre += (b2 < blk) ? t : 0.f; }
#pragma unroll
    for (int i16 = 0; i16 < 16; ++i16) bcd[i16] += pre;
    return blast;
}
__device__ __forceinline__ void gla_upd_items(LAS unsigned char* lds, const bf16* __restrict__ Z, const float* __restrict__ Wa, const float* __restrict__ ba, bf16* __restrict__ Ug, float* __restrict__ Gg, int G, int bx, int wave, int lane) {
    const int h2 = wave >> 2, w4 = wave & 3, i = lane & 15, g = lane >> 4, t2 = w4 * 64 + lane;
    LAS unsigned char* Ku = lds + h2 * GU_HALF; LAS unsigned char* Vt = Ku + 64 * P64; LAS float* gaL = (LAS float*)(Vt + T64x128); LAS float* tot = gaL + 1024;
    for (int p = bx; p < B_ * GLA_H * NCH / 2; p += G) {
        const int item = 2 * p + h2, n = item & 127, bh = item >> 7, h = bh & 3, b = bh >> 2; const size_t row0 = (size_t)b * S_ + n * CH;
#pragma unroll
        for (int u = 0; u < 4; ++u) { const int c = t2 + 256 * u; *(LAS u32x4*)(Vt + (c >> 4) * P128 + (c & 15) * 16) = *(const u32x4*)(Z + (row0 + (c >> 4)) * ZLD + O_GV + h * GDV + (c & 15) * 8); }
        float bcd[16]; const float blast = gla_decay(gaL, tot, Z, row0, Wa, ba, h, t2, bcd);
        const int d = t2 & 63, blk = t2 >> 6;
#pragma unroll
        for (int i16 = 0; i16 < 16; ++i16) { const int c = 16 * blk + i16; const float kv = bf2f(Z[(row0 + c) * ZLD + O_GK + h * GDK + d]);
            *(LAS bf16*)(Ku + c * P64 + 2 * d) = (bf16)f2bf(kv * __expf(blast - bcd[i16])); }
        if (blk == 0) Gg[(size_t)item * 64 + d] = __expf(blast);
        __syncthreads();
        f32x4 acc[2][4];
#pragma unroll
        for (int ee = 0; ee < 2; ++ee)
#pragma unroll
            for (int dt = 0; dt < 4; ++dt) acc[ee][dt] = (f32x4){0.f, 0.f, 0.f, 0.f};
#pragma unroll
        for (int ks = 0; ks < 2; ++ks) { const bf16x8 a0 = frag_tr(Vt, P128, 32 * ks + 8 * g, 32 * ks + 8 * g + 4, 16 * (2 * w4), lane), a1 = frag_tr(Vt, P128, 32 * ks + 8 * g, 32 * ks + 8 * g + 4, 16 * (2 * w4 + 1), lane);
#pragma unroll
            for (int dt = 0; dt < 4; ++dt) { const bf16x8 kf = frag_tr(Ku, P64, 32 * ks + 8 * g, 32 * ks + 8 * g + 4, 16 * dt, lane); acc[0][dt] = MFMA16(a0, kf, acc[0][dt]); acc[1][dt] = MFMA16(a1, kf, acc[1][dt]); } }
        bf16* Uo = Ug + (size_t)item * 8192 + (size_t)i * 128 + 32 * w4 + 4 * g;
#pragma unroll
        for (int ee = 0; ee < 2; ++ee)
#pragma unroll
            for (int dt = 0; dt < 4; ++dt) { u32x2 w; w.x = cvt_pk_bf16(acc[ee][dt][0], acc[ee][dt][1]); w.y = cvt_pk_bf16(acc[ee][dt][2], acc[ee][dt][3]); *(u32x2*)(Uo + (size_t)dt * 16 * 128 + 16 * ee) = w; }
        __syncthreads();
    }
}
__device__ __forceinline__ void scan_items(const bf16* __restrict__ Ur, bf16* __restrict__ Sr, const bf16* __restrict__ Ug, const float* __restrict__ Gg, bf16* __restrict__ Sg, int mixf, int G, int bx, int tid) {
    constexpr int NRET = 12 * 128 * 64, NALL = NRET + 8 * 64 * 64;
    for (int task = bx * NTHR + tid; task < NALL; task += G * NTHR) {
        if (task < NRET) { if (!(mixf & 2)) continue;
            const int e2 = task & 63, d = (task >> 6) & 127, bh = task >> 13; const float dec = __expf(lgam(bh % RET_H) * 64.0f);
            const bf16* up = Ur + (size_t)bh * NCH * 16384 + d * 128 + 2 * e2; bf16* sp = Sr + (size_t)bh * NCH * 16384 + d * 128 + 2 * e2;
            float s0 = 0.f, s1 = 0.f;
#pragma unroll 16
            for (int n = 0; n < NCH; ++n) { const unsigned u = *(const unsigned*)(up + (size_t)n * 16384); *(unsigned*)(sp + (size_t)n * 16384) = cvt_pk_bf16(s0, s1); s0 = dec * s0 + __uint_as_float(u << 16); s1 = dec * s1 + __uint_as_float(u & 0xffff0000u); }
        } else { if (!(mixf & 4)) continue;
            const int t2 = task - NRET, e2 = t2 & 63, d = (t2 >> 6) & 63, bh = t2 >> 12;
            const bf16* up = Ug + (size_t)bh * NCH * 8192 + d * 128 + 2 * e2; bf16* sp = Sg + (size_t)bh * NCH * 8192 + d * 128 + 2 * e2; const float* gp = Gg + (size_t)bh * NCH * 64 + d;
            float s0 = 0.f, s1 = 0.f;
#pragma unroll 16
            for (int n = 0; n < NCH; ++n) { const unsigned u = *(const unsigned*)(up + (size_t)n * 8192); const float gd = gp[n * 64]; *(unsigned*)(sp + (size_t)n * 8192) = cvt_pk_bf16(s0, s1); s0 = gd * s0 + __uint_as_float(u << 16); s1 = gd * s1 + __uint_as_float(u & 0xffff0000u); }
        }
    }
}
__device__ __forceinline__ void ret_out_items(LAS unsigned char* lds, const bf16* __restrict__ Z, const bf16* __restrict__ Sr, bf16* __restrict__ Y, int G, int bx, int wave, int lane) {
    const int h2 = wave >> 2, w4 = wave & 3, i = lane & 15, g = lane >> 4, t2 = w4 * 64 + lane;
    LAS unsigned char* Kr = lds + h2 * RO_HALF; LAS unsigned char* Vt = Kr + T64x128; LAS unsigned char* St = Vt + T64x128;
    for (int p = bx; p < B_ * RET_H * NCH / 2; p += G) {
        const int item = 2 * p + h2, n = item & 127, bh = item >> 7, h = bh % RET_H, b = bh / RET_H; const float lg = lgam(h); const size_t row0 = (size_t)b * S_ + n * CH;
#pragma unroll
        for (int u = 0; u < 4; ++u) { const int c = t2 + 256 * u, row = c >> 4, ch = c & 15; const bf16* zp = Z + (row0 + row) * ZLD + h * HD + ch * 8;
            *(LAS u32x4*)(Kr + row * P128 + ch * 16) = *(const u32x4*)(zp + O_RK); *(LAS u32x4*)(Vt + row * P128 + ch * 16) = *(const u32x4*)(zp + O_RV); }
#pragma unroll
        for (int u = 0; u < 8; ++u) { const int c = t2 + 256 * u; *(LAS u32x4*)(St + (c >> 4) * P128 + (c & 15) * 16) = *(const u32x4*)(Sr + (size_t)item * 16384 + (c >> 4) * 128 + (c & 15) * 8); }
        const int c = 16 * w4 + i;
        bf16x8 qf[4];
#pragma unroll
        for (int s = 0; s < 4; ++s) qf[s] = *(const bf16x8*)(Z + (row0 + c) * ZLD + O_RQ + h * HD + 32 * s + 8 * g);
        __syncthreads();
        f32x4 sc[4];
#pragma unroll
        for (int mt = 0; mt < 4; ++mt) { sc[mt] = (f32x4){0.f, 0.f, 0.f, 0.f};
#pragma unroll
            for (int s = 0; s < 4; ++s) sc[mt] = MFMA16(frag_row(Kr, P128, 16 * mt, 32 * s, lane), qf[s], sc[mt]);
#pragma unroll
            for (int r = 0; r < 4; ++r) { const int l = 16 * mt + 4 * g + r; sc[mt][r] *= __expf(lg * (float)(c > l ? c - l : l - c)); } }
        f32x4 o[8];
#pragma unroll
        for (int et = 0; et < 8; ++et) o[et] = (f32x4){0.f, 0.f, 0.f, 0.f};
#pragma unroll
        for (int ks = 0; ks < 4; ++ks)
#pragma unroll
            for (int et = 0; et < 8; ++et) o[et] = MFMA16(frag_tr(St, P128, 32 * ks + 8 * g, 32 * ks + 8 * g + 4, 16 * et, lane), qf[ks], o[et]);
        const float xi = __expf(lg * (float)(c + 1));
#pragma unroll
        for (int et = 0; et < 8; ++et) o[et] = o[et] * xi;
#pragma unroll
        for (int ks = 0; ks < 2; ++ks) { const bf16x8 pf = pack8(sc[2 * ks], sc[2 * ks + 1]);
#pragma unroll
            for (int et = 0; et < 8; ++et) o[et] = MFMA16(frag_tr(Vt, P128, 32 * ks + 4 * g, 32 * ks + 16 + 4 * g, 16 * et, lane), pf, o[et]); }
        float s1 = 0.f, s2 = 0.f;
#pragma unroll
        for (int et = 0; et < 8; ++et)
#pragma unroll
            for (int r = 0; r < 4; ++r) { s1 += o[et][r]; s2 += o[et][r] * o[et][r]; }
        s1 += sx16(s1); s1 += sx32(s1, lane); s2 += sx16(s2); s2 += sx32(s2, lane);
        const float mu = s1 * (1.0f / HD), rs = rsqrtf(s2 * (1.0f / HD) - mu * mu + EPS);
        const bf16* gp = Z + (row0 + c) * ZLD + O_RG + h * HD + 4 * g; bf16* yo = Y + (row0 + c) * D_ + h * HD + 4 * g;
#pragma unroll
        for (int et = 0; et < 8; ++et) { const u32x2 gw = *(const u32x2*)(gp + 16 * et);
            const float g0 = __uint_as_float(gw.x << 16), g1 = __uint_as_float(gw.x & 0xffff0000u), g2 = __uint_as_float(gw.y << 16), g3 = __uint_as_float(gw.y & 0xffff0000u);
            u32x2 w; w.x = cvt_pk_bf16((o[et][0] - mu) * rs * silu_f(g0), (o[et][1] - mu) * rs * silu_f(g1)); w.y = cvt_pk_bf16((o[et][2] - mu) * rs * silu_f(g2), (o[et][3] - mu) * rs * silu_f(g3));
            *(u32x2*)(yo + 16 * et) = w; }
        __syncthreads();
    }
}
__device__ __forceinline__ void gla_out_items(LAS unsigned char* lds, const bf16* __restrict__ Z, const float* __restrict__ Wa, const float* __restrict__ ba, const bf16* __restrict__ Sg, bf16* __restrict__ Y, int G, int bx, int wave, int lane) {
    const int h2 = wave >> 2, w4 = wave & 3, i = lane & 15, g = lane >> 4, t2 = w4 * 64 + lane;
    LAS unsigned char* Qi = lds + h2 * GO_HALF; LAS unsigned char* Ki = Qi + 64 * P64; LAS unsigned char* Vt = Ki + 64 * P64; LAS unsigned char* St = Vt + T64x128;
    LAS float* gaL = (LAS float*)(St + T64x128); LAS float* tot = gaL + 1024;
    for (int p = bx; p < B_ * GLA_H * NCH / 2; p += G) {
        const int item = 2 * p + h2, n = item & 127, bh = item >> 7, h = bh & 3, b = bh >> 2; const size_t row0 = (size_t)b * S_ + n * CH;
#pragma unroll
        for (int u = 0; u < 4; ++u) { const int c = t2 + 256 * u; *(LAS u32x4*)(Vt + (c >> 4) * P128 + (c & 15) * 16) = *(const u32x4*)(Z + (row0 + (c >> 4)) * ZLD + O_GV + h * GDV + (c & 15) * 8);
            *(LAS u32x4*)(St + (c >> 4) * P128 + (c & 15) * 16) = *(const u32x4*)(Sg + (size_t)item * 8192 + (c >> 4) * 128 + (c & 15) * 8); }
        float bcd[16]; (void)gla_decay(gaL, tot, Z, row0, Wa, ba, h, t2, bcd);
        { const int d = t2 & 63, blk = t2 >> 6;
#pragma unroll
          for (int i16 = 0; i16 < 16; ++i16) { const int c = 16 * blk + i16; const float qv = bf2f(Z[(row0 + c) * ZLD + O_GQ + h * GDK + d]), kv = bf2f(Z[(row0 + c) * ZLD + O_GK + h * GDK + d]);
              *(LAS bf16*)(Qi + c * P64 + 2 * d) = (bf16)f2bf(qv * 0.125f * __expf(bcd[i16])); *(LAS bf16*)(Ki + c * P64 + 2 * d) = (bf16)f2bf(kv * __expf(-bcd[i16])); } }
        __syncthreads();
        const int c = 16 * w4 + i;
        bf16x8 qf[2];
#pragma unroll
        for (int s = 0; s < 2; ++s) qf[s] = frag_row(Qi, P64, 16 * w4, 32 * s, lane);
        f32x4 sc[4];
#pragma unroll
        for (int mt = 0; mt < 4; ++mt) { sc[mt] = (f32x4){0.f, 0.f, 0.f, 0.f};
#pragma unroll
            for (int s = 0; s < 2; ++s) sc[mt] = MFMA16(frag_row(Ki, P64, 16 * mt, 32 * s, lane), qf[s], sc[mt]);
#pragma unroll
            for (int r = 0; r < 4; ++r) { const int l = 16 * mt + 4 * g + r; sc[mt][r] = (c >= l) ? sc[mt][r] : 0.f; } }
        f32x4 o[8];
#pragma unroll
        for (int et = 0; et < 8; ++et) o[et] = (f32x4){0.f, 0.f, 0.f, 0.f};
#pragma unroll
        for (int ks = 0; ks < 2; ++ks)
#pragma unroll
            for (int et = 0; et < 8; ++et) o[et] = MFMA16(frag_tr(St, P128, 32 * ks + 8 * g, 32 * ks + 8 * g + 4, 16 * et, lane), qf[ks], o[et]);
#pragma unroll
        for (int ks = 0; ks < 2; ++ks) { const bf16x8 pf = pack8(sc[2 * ks], sc[2 * ks + 1]);
#pragma unroll
            for (int et = 0; et < 8; ++et) o[et] = MFMA16(frag_tr(Vt, P128, 32 * ks + 4 * g, 32 * ks + 16 + 4 * g, 16 * et, lane), pf, o[et]); }
        float s2 = 0.f;
#pragma unroll
        for (int et = 0; et < 8; ++et)
#pragma unroll
            for (int r = 0; r < 4; ++r) s2 += o[et][r] * o[et][r];
        s2 += sx16(s2); s2 += sx32(s2, lane);
        const float rs = rsqrtf(s2 * (1.0f / GDV) + EPS);
        const bf16* gp = Z + (row0 + c) * ZLD + O_GG + h * GDV + 4 * g; bf16* yo = Y + (row0 + c) * D_ + 768 + h * GDV + 4 * g;
#pragma unroll
        for (int et = 0; et < 8; ++et) { const u32x2 gw = *(const u32x2*)(gp + 16 * et);
            const float g0 = __uint_as_float(gw.x << 16), g1 = __uint_as_float(gw.x & 0xffff0000u), g2 = __uint_as_float(gw.y << 16), g3 = __uint_as_float(gw.y & 0xffff0000u);
            u32x2 w; w.x = cvt_pk_bf16(o[et][0] * rs * silu_f(g0), o[et][1] * rs * silu_f(g1)); w.y = cvt_pk_bf16(o[et][2] * rs * silu_f(g2), o[et][3] * rs * silu_f(g3));
            *(u32x2*)(yo + 16 * et) = w; }
        __syncthreads();
    }
}
}

#define XB_TMO      128
#define XB_XCNT(j)  (256  + 64 * (j))
#define XB_XSUB(j)  (1280 + 64 * (j))
#define XB_XGEN(j)  (2304 + 64 * (j))
#define XB_TOP      3328
#define XB_TOPGEN   3392
#define XCD_BAR_WORDS 3456
#define XB_SPIN_CAP (1u << 18)
__device__ __forceinline__ unsigned xb_ld(unsigned* p)              { return __hip_atomic_load(p, __ATOMIC_RELAXED, __HIP_MEMORY_SCOPE_AGENT); }
__device__ __forceinline__ unsigned xb_add(unsigned* p, unsigned v) { return __hip_atomic_fetch_add(p, v, __ATOMIC_RELAXED, __HIP_MEMORY_SCOPE_AGENT); }
__device__ __forceinline__ unsigned xb_xcc_id() { return (unsigned)__builtin_amdgcn_s_getreg((3 << 11) | 20) & 0xFu; }
#define XB_SPIN(cond, bar) do { unsigned _sp = 0; while (cond) { __builtin_amdgcn_s_sleep(1); \
    if ((++_sp & 255u) == 0u) { if (xb_ld(&(bar)[XB_TMO])) break; if (_sp > XB_SPIN_CAP) { atomicAdd(&(bar)[XB_TMO], 1u); break; } } } } while (0)
struct XcdBarrier { unsigned* bar; unsigned x; volatile LAS unsigned* st; };
__device__ __forceinline__ XcdBarrier xcd_barrier_post(unsigned* bar, volatile LAS unsigned* st) {
    XcdBarrier b; b.bar = bar; b.x = xb_xcc_id(); b.st = st;
    if (threadIdx.x == 0) (void)xb_add(&bar[XB_XCNT(b.x)], 1u);
    return b;
}
__device__ __forceinline__ void xcd_barrier_complete(unsigned* bar, unsigned x, unsigned& nloc, unsigned& nx) {
    const unsigned G = gridDim.x * gridDim.y * gridDim.z;
    unsigned sum, cnt, mine, sp = 0u;
    for (;;) {
        sum = 0u; cnt = 0u; mine = 0u;
#pragma unroll
        for (unsigned j = 0; j < 16; ++j) { const unsigned c = xb_ld(&bar[XB_XCNT(j)]); sum += c; cnt += (c > 0u) ? 1u : 0u; mine = (j == x) ? c : mine; }
        if (sum == G) break;
        __builtin_amdgcn_s_sleep(1);
        if ((++sp & 255u) == 0u) { if (xb_ld(&bar[XB_TMO])) break; if (sp > XB_SPIN_CAP) { atomicAdd(&bar[XB_TMO], 1u); break; } }
    }
    nloc = mine > 0u ? mine : 1u; nx = cnt > 0u ? cnt : 1u;
}
__device__ __forceinline__ void xcd_barrier(const XcdBarrier& b) {
    asm volatile("s_waitcnt vmcnt(0)" ::: "memory");
    __syncthreads();
    if (threadIdx.x == 0) {
        unsigned* bar = b.bar;
        __builtin_amdgcn_s_waitcnt(0);
        unsigned nloc = b.st[0], nx = b.st[1];
        if (nloc == 0u) { xcd_barrier_complete(bar, b.x, nloc, nx); b.st[0] = nloc; b.st[1] = nx; }
        const unsigned old = xb_add(&bar[XB_XSUB(b.x)], 1u);
        const unsigned gen = old / nloc;
        if (old + 1u == (gen + 1u) * nloc) {
            __builtin_amdgcn_fence(__ATOMIC_RELEASE, "agent");
            asm volatile("s_waitcnt vmcnt(0)" ::: "memory");
            const unsigned og = xb_add(&bar[XB_TOP], 1u);
            const unsigned tg = og / nx;
            if (og + 1u == (tg + 1u) * nx) xb_add(&bar[XB_TOPGEN], 1u);
            else XB_SPIN(xb_ld(&bar[XB_TOPGEN]) == tg, bar);
            __builtin_amdgcn_fence(__ATOMIC_ACQUIRE, "agent");
            xb_add(&bar[XB_XGEN(b.x)], 1u);
            asm volatile("s_waitcnt vmcnt(0)" ::: "memory");
        } else {
            XB_SPIN(xb_ld(&bar[XB_XGEN(b.x)]) == gen, bar);
            __builtin_amdgcn_fence(__ATOMIC_ACQUIRE, "agent");
            asm volatile("s_waitcnt vmcnt(0)" ::: "memory");
        }
    }
    __syncthreads();
}

constexpr int RING_OFF = 0, RING_BYTES = 131072;
constexpr int MISC_OFF = 147456;
constexpr int LDS_BYTES = MISC_OFF + 10240;
static_assert(2 * mx::RO_HALF <= MISC_OFF && 2 * mx::GO_HALF <= MISC_OFF && LDS_BYTES <= 163840, "LDS map");

#ifndef PROBE_REP
#define PROBE_REP 0
#endif
#ifndef PROBE_SITES
#define PROBE_SITES 0xffffffffu
#endif
#if PROBE_REP
#define REPEAT(k) for (int rep_ = 0; rep_ <= (((PROBE_SITES >> (k)) & 1u) ? ((argp()->rep >> (k)) & 1) : 0); ++rep_)
#else
#define REPEAT(k) for (int rep_ = 0; rep_ < 1; ++rep_)
#endif
#define DRY_XB(ws) ((bf16*)((ws) + WS_Z + (size_t)T_ * D_ * 2))
#define DRY_SS(ws) ((float*)((ws) + WS_Z + (size_t)T_ * D_ * 6))
#define DRY_ENT(ws) ((u32x4*)((ws) + WS_Z))
struct Args { const float* in[21]; float* out; unsigned char* ws; int l_lo, l_hi, ph_lo, ph_hi, do_pro, do_fin, use_bar, mix, rep, pad; };

template <class RowMap>
__device__ __forceinline__ void transpose_item(const float* __restrict__ W, int ldn, int nmax, int k0, int n0, const float* __restrict__ s, bf16* __restrict__ WT, int ldk, int dk0, RowMap drow, LAS float* scr, int lane) {
    float v[32]; const int n_in = n0 + (lane & 31); const float* wp = W + (size_t)(k0 + (lane >> 5)) * ldn + n_in;
#pragma unroll
    for (int i = 0; i < 32; ++i) v[i] = (n_in < nmax) ? wp[(size_t)(2 * i) * ldn] : 0.f;
    const int c = lane & 7;
    f32x4 s0 = {1.f, 1.f, 1.f, 1.f}, s1 = s0;
    if (s) { s0 = *(const f32x4*)(s + k0 + 8 * c); s1 = *(const f32x4*)(s + k0 + 8 * c + 4); }
#pragma unroll
    for (int i = 0; i < 32; ++i) scr[(2 * i + (lane >> 5)) * 33 + (lane & 31)] = v[i];
    LDS_WAIT(); asm volatile("" ::: "memory");
#pragma unroll
    for (int j = 0; j < 4; ++j) { const int nl = (lane >> 3) + 8 * j, n = n0 + nl; const LAS float* sp = scr + (8 * c) * 33 + nl;
        u32x4 o; o.x = pk2(sp[0 * 33] * s0[0], sp[1 * 33] * s0[1]); o.y = pk2(sp[2 * 33] * s0[2], sp[3 * 33] * s0[3]); o.z = pk2(sp[4 * 33] * s1[0], sp[5 * 33] * s1[1]); o.w = pk2(sp[6 * 33] * s1[2], sp[7 * 33] * s1[3]);
        if (n < nmax) *(u32x4*)(WT + (size_t)drow(n) * ldk + dk0 + k0 + 8 * c) = o; }
    LDS_WAIT(); asm volatile("" ::: "memory");
}

typedef const __attribute__((address_space(4))) Args* CArgsP;
__device__ __forceinline__ CArgsP argp() {
    unsigned long long v = (unsigned long long)(CArgsP)__builtin_amdgcn_kernarg_segment_ptr(); unsigned lo = (unsigned)v, hi = (unsigned)(v >> 32);
    asm volatile("" : "+s"(lo), "+s"(hi));
    lo = __builtin_amdgcn_readfirstlane(lo); hi = __builtin_amdgcn_readfirstlane(hi);
    return (CArgsP)(((unsigned long long)hi << 32) | lo);
}
__global__ void __launch_bounds__(NTHR, 2) mk_fwd(Args args_unused) {
    extern __shared__ __attribute__((aligned(16))) unsigned char lds_raw[];
    LAS unsigned char* lds = (LAS unsigned char*)lds_raw;
    volatile LAS unsigned* MISC = (volatile LAS unsigned*)(lds + MISC_OFF);
    for (int u = threadIdx.x; u < 256; u += NTHR) MISC[u] = 0u;
    const int wave_s = __builtin_amdgcn_readfirstlane(threadIdx.x >> 6);
    __syncthreads();
    if (argp()->use_bar) (void)xcd_barrier_post((unsigned*)(argp()->ws + WS_CTL) + CW_BAR, MISC + 8);
#define GRID_BAR() do { CArgsP ap_ = argp(); if (ap_->use_bar) { XcdBarrier bar_; bar_.bar = (unsigned*)(ap_->ws + WS_CTL) + CW_BAR; bar_.x = xb_xcc_id(); bar_.st = MISC + 8; xcd_barrier(bar_); } } while (0)
#define PHASE_VARS() CArgsP ap = argp(); unsigned char* ws = ap->ws; float* ssb = (float*)(ws + WS_SSP); float* X = ap->out; \
    const int G = gridDim.x, bx = blockIdx.x; (void)ssb; (void)X; (void)G; (void)bx
#define WAVE_VARS() const int lane = lane_opaque(), wave = wave_s; \
    const int vcu = (G % 8 == 0) ? (bx % 8) * (G / 8) + bx / 8 : bx; const int gw = vcu * NWAVES + wave, NGW = G * NWAVES; (void)lane; (void)gw; (void)NGW

    if (argp()->do_pro) {
        REPEAT(0) {
        PHASE_VARS(); WAVE_VARS();
        LAS float* scr = (LAS float*)(lds + RING_OFF + wave * 16384);
        for (int l = 0; l < DEPTH_; ++l) {
            { const float* W = ap->in[3] + (size_t)l * D_ * DIN; const float* s = ap->in[2] + l * D_; bf16* WT = (bf16*)(ws + WS_WIN) + (size_t)l * ZLD * D_;
              constexpr int NB = (DIN + 31) / 32;
              for (int it = gw; it < 32 * NB; it += NGW) { const int kb = it / NB, nb = it % NB;
                  transpose_item(W, DIN, DIN, kb * 64, nb * 32, s, WT, D_, 0, [](int n) { if (n < 1536) { const int d = n & 127; return (n & ~127) + ((d < 64) ? 8 * (d >> 2) + (d & 3) : 8 * ((d - 64) >> 2) + 4 + (d & 3)); } return n < 4608 ? n : (n < 4624 ? n + 2304 : n - 16); }, scr, lane); }
              for (int i = gw * 64 + lane; i < (ZLD - DIN) * D_ / 8; i += NGW * 64) *(u32x4*)(WT + (size_t)DIN * D_ + (size_t)i * 8) = (u32x4){0u, 0u, 0u, 0u}; }
            { const float* W = ap->in[8] + (size_t)l * D_ * D_; const float* s = ap->in[7] + l * D_; bf16* WT = (bf16*)(ws + WS_WOUT) + (size_t)l * D_ * D_;
              for (int it = gw; it < 32 * 64; it += NGW) transpose_item(W, D_, D_, (it / 64) * 64, (it % 64) * 32, s, WT, D_, 0, [](int n) { return n; }, scr, lane); }
            { const float* W = ap->in[18] + (size_t)l * D_ * D_; const float* s = ap->in[17] + l * D_; bf16* WT = (bf16*)(ws + WS_WPG) + (size_t)l * D_ * D_;
              for (int it = gw; it < 32 * 64; it += NGW) transpose_item(W, D_, D_, (it / 64) * 64, (it % 64) * 32, s, WT, D_, 0, [](int n) { return n; }, scr, lane); }
            { const float* W = ap->in[19] + (size_t)l * PLE * D_; bf16* WT = (bf16*)(ws + WS_WPP) + (size_t)l * D_ * PLE;
              for (int it = gw; it < 4 * 64; it += NGW) transpose_item(W, D_, D_, (it / 64) * 64, (it % 64) * 32, (const float*)nullptr, WT, PLE, 0, [](int n) { return n; }, scr, lane); }
        }
        for (int l = 0; l < DEPTH_; ++l) {
            { const float* s = ap->in[9] + l * D_;
              for (int it = gw; it < 32 * 2 * 256; it += NGW) { const int ge = it >> 9, mat = (it >> 8) & 1, kb = (it & 255) >> 3, nb = it & 7;
                  const float* W = ap->in[14 + mat] + ((size_t)l * 32 + ge) * D_ * FF; bf16* WT = (bf16*)(ws + WS_WGU) + ((size_t)l * 32 + ge) * 512 * D_;
                  transpose_item(W, FF, FF, kb * 64, nb * 32, s, WT, D_, 0, [mat](int n) { return (n >> 7) * 256 + mat * 128 + (n & 127); }, scr, lane); } }
            { for (int it = gw; it < 32 * 256; it += NGW) { const int ge = it >> 8, kb = (it & 255) >> 6, nb = it & 63;
                  const float* W = ap->in[16] + ((size_t)l * 32 + ge) * FF * D_; bf16* WT = (bf16*)(ws + WS_WD) + ((size_t)l * 4 + (ge >> 3)) * D_ * D_;
                  transpose_item(W, D_, D_, kb * 64, nb * 32, (const float*)nullptr, WT, D_, (ge & 7) * 256, [](int n) { return n; }, scr, lane); } }
            { float* WR = (float*)(ws + WS_WR) + (size_t)l * 48 * D_; const float* s = ap->in[9] + l * D_; const float* wg = ap->in[10] + (size_t)l * D_ * 4; const float* we = ap->in[12] + (size_t)l * D_ * 32;
              for (int i = gw * 64 + lane; i < 48 * D_; i += NGW * 64) { const int j = i >> 11, k = i & 2047;
                  WR[i] = (j < 4) ? s[k] * wg[k * 4 + j] : (j < 36 ? s[k] * we[k * 32 + (j - 4)] : 0.f); } }
        }
        { float* RT = (float*)(ws + WS_ROT);
          for (int idx = gw * 64 + lane; idx < S_ * 64; idx += NGW * 64) { const float inv = 1.0f / powf(10000.0f, (float)(idx & 63) / 64.0f); float sn, cs; sincosf((float)(idx >> 6) * inv, &sn, &cs); RT[idx] = cs; RT[S_ * 64 + idx] = sn; } }
        { const float* P = ap->in[1]; bf16* PB = (bf16*)(ws + WS_PB);
          for (size_t i = (size_t)gw * 64 + lane; i < (size_t)DEPTH_ * T_ * PLE / 8; i += (size_t)NGW * 64) { const f32x4 a = *(const f32x4*)(P + i * 8), b = *(const f32x4*)(P + i * 8 + 4);
              u32x4 o; o.x = pk2(a[0], a[1]); o.y = pk2(a[2], a[3]); o.z = pk2(b[0], b[1]); o.w = pk2(b[2], b[3]); *(u32x4*)(PB + i * 8) = o; } }
        { const float* xin = ap->in[0]; bf16* XB = (bf16*)(ws + WS_XB0);
          for (int m = gw; m < T_; m += NGW) { const f32x4* xr = (const f32x4*)(xin + (size_t)m * D_) + lane; f32x4 v[8]; float s = 0.f;
#pragma unroll
              for (int j = 0; j < 8; ++j) { v[j] = xr[64 * j]; s += (v[j][0] * v[j][0] + v[j][1] * v[j][1]) + (v[j][2] * v[j][2] + v[j][3] * v[j][3]); }
              s = wave_sum(s);
#pragma unroll
              for (int j = 0; j < 8; ++j) { u32x2 o; o.x = pk2(v[j][0], v[j][1]); o.y = pk2(v[j][2], v[j][3]); *((u32x2*)(XB + (size_t)m * D_) + lane + 64 * j) = o; }
              if (lane < 8) ssb[(size_t)lane * T_ + m] = (lane == 0) ? s : 0.f; } }
        }
        GRID_BAR();
    }

    for (int l = argp()->l_lo; l < argp()->l_hi; ++l) {
#define IN(k) (argp()->ph_lo <= (k) && (k) < argp()->ph_hi)
#define LAYER_VARS() const int cur = l & 1; bf16* XBc = (bf16*)(ws + (cur ? WS_XB1 : WS_XB0)); bf16* XBn = (bf16*)(ws + (cur ? WS_XB0 : WS_XB1)); \
        float* ss0 = ssb + (size_t)(l * 3 + 0) * 8 * T_; float* ss1 = ssb + (size_t)(l * 3 + 1) * 8 * T_; float* ss2 = ssb + (size_t)(l * 3 + 2) * 8 * T_; float* ss3 = ssb + (size_t)(l * 3 + 3) * 8 * T_; \
        (void)XBc; (void)XBn; (void)ss0; (void)ss1; (void)ss2; (void)ss3
        if (IN(1)) {
            PHASE_VARS(); LAYER_VARS();
            pg8::DenseOrder S; S.init(XBc, (bf16*)(ws + WS_WIN) + (size_t)l * ZLD * D_, T_, ZLD, D_, D_, G, bx);
            pg8::EpiZ E{(bf16*)(ws + WS_Z), ss0, (const float*)(ws + WS_ROT)};
            REPEAT(1) pg8::gemm_phase<pg8::EpiZ, pg8::DenseOrder, false, true>(lds + RING_OFF, wave_s, D_, D_, D_, S, E);
            GRID_BAR();
        }
        if (IN(2)) {
            PHASE_VARS(); WAVE_VARS();
            REPEAT(10) if (ap->mix & 1) mx::attn_items(lds + RING_OFF, (const bf16*)(ws + WS_Z), ap->in[6] + (size_t)l * ATT_H * 257, (bf16*)(ws + WS_Y), G, bx, wave, lane);
            REPEAT(11) if (ap->mix & 2) mx::ret_upd_items(lds + RING_OFF, (const bf16*)(ws + WS_Z), (bf16*)(ws + WS_SCR + SC_UR), G, bx, wave, lane);
            REPEAT(12) if (ap->mix & 4) mx::gla_upd_items(lds + RING_OFF, (const bf16*)(ws + WS_Z), ap->in[4] + (size_t)l * GRANK * 256, ap->in[5] + l * 256, (bf16*)(ws + WS_SCR + SC_UG), (float*)(ws + WS_SCR + SC_GG), G, bx, wave, lane);
            GRID_BAR();
        }
        if (IN(3)) {
            PHASE_VARS(); WAVE_VARS();
            REPEAT(3) mx::scan_items((const bf16*)(ws + WS_SCR + SC_UR), (bf16*)(ws + WS_SCR + SC_SR), (const bf16*)(ws + WS_SCR + SC_UG), (const float*)(ws + WS_SCR + SC_GG), (bf16*)(ws + WS_SCR + SC_SG), ap->mix, G, bx, wave * 64 + lane);
            GRID_BAR();
        }
        if (IN(4)) {
            PHASE_VARS(); WAVE_VARS();
            REPEAT(13) if (ap->mix & 2) mx::ret_out_items(lds + RING_OFF, (const bf16*)(ws + WS_Z), (const bf16*)(ws + WS_SCR + SC_SR), (bf16*)(ws + WS_Y), G, bx, wave, lane);
            REPEAT(14) if (ap->mix & 4) mx::gla_out_items(lds + RING_OFF, (const bf16*)(ws + WS_Z), ap->in[4] + (size_t)l * GRANK * 256, ap->in[5] + l * 256, (const bf16*)(ws + WS_SCR + SC_SG), (bf16*)(ws + WS_Y), G, bx, wave, lane);
            GRID_BAR();
        }
        if (IN(5)) {
            { PHASE_VARS(); LAYER_VARS();
              pg8::DenseOrder S; S.init(ws + WS_Y, (bf16*)(ws + WS_WOUT) + (size_t)l * D_ * D_, T_, D_, D_, D_, G, bx);
              REPEAT(5) { pg8::EpiRes E{XBc, rep_ ? DRY_XB(ws) : XBn, rep_ ? DRY_SS(ws) : ss1, (LAS float*)(lds + MISC_OFF + 1024)};
              pg8::gemm_phase<pg8::EpiRes, pg8::DenseOrder, false, true>(lds + RING_OFF, wave_s, D_, D_, D_, S, E); } }
            { PHASE_VARS();
              pg8::DenseOrder S; S.init((bf16*)(ws + WS_PB) + (size_t)l * T_ * PLE, (bf16*)(ws + WS_WPP) + (size_t)l * D_ * PLE, T_, D_, PLE, PLE, G, bx);
              pg8::EpiB E{(bf16*)(ws + WS_PROJ), D_};
              REPEAT(15) pg8::gemm_phase<pg8::EpiB, pg8::DenseOrder, false, true>(lds + RING_OFF, wave_s, PLE, PLE, PLE, S, E); }
            GRID_BAR();
        }
        if (IN(6)) {
            PHASE_VARS(); LAYER_VARS(); WAVE_VARS();
            const float* Wr = (const float*)(ws + WS_WR) + (size_t)l * 48 * D_;
            const float* brg = ap->in[11] + l * 4; const float* bre = ap->in[13] + l * 32;
            LAS float* L = (LAS float*)(lds + RING_OFF);
            REPEAT(6) {
            unsigned* cnt = (unsigned*)(ws + WS_CTL) + CW_CNT + (rep_ ? 1024 : 0) + l * 128;
            u32x4* ent = rep_ ? DRY_ENT(ws) : (u32x4*)(ws + WS_SCR + SC_ENT);
            for (int grp0 = vcu * 4; grp0 < T_ / 16; grp0 += G * 4) {
                const int grp = grp0 + (wave >> 1), kh = wave & 1, i = lane & 15, q = lane >> 4;
                const bf16* xa = XBn + (size_t)(grp * 16 + i) * D_ + kh * 1024 + 4 * q;
                const float* wb = Wr + (size_t)i * D_ + kh * 1024 + 4 * q;
                f32x4 a0 = {0.f, 0.f, 0.f, 0.f}, a1 = a0, a2 = a0;
#pragma unroll 4
                for (int st = 0; st < 64; ++st) {
                    const u32x2 xw = *(const u32x2*)(xa + 16 * st); const f32x4 xv = {__uint_as_float(xw.x << 16), __uint_as_float(xw.x & 0xffff0000u), __uint_as_float(xw.y << 16), __uint_as_float(xw.y & 0xffff0000u)}; const f32x4 w0 = *(const f32x4*)(wb + 16 * st), w1 = *(const f32x4*)(wb + 16 * D_ + 16 * st), w2 = *(const f32x4*)(wb + 32 * D_ + 16 * st);
#pragma unroll
                    for (int c = 0; c < 4; ++c) { a0 = __builtin_amdgcn_mfma_f32_16x16x4f32(xv[c], w0[c], a0, 0, 0, 0); a1 = __builtin_amdgcn_mfma_f32_16x16x4f32(xv[c], w1[c], a1, 0, 0, 0); a2 = __builtin_amdgcn_mfma_f32_16x16x4f32(xv[c], w2[c], a2, 0, 0, 0); }
                }
                LAS float* Lw = L + ((wave >> 1) * 2 + kh) * 768;
#pragma unroll
                for (int r = 0; r < 4; ++r) { Lw[(4 * q + r) * 48 + i] = a0[r]; Lw[(4 * q + r) * 48 + 16 + i] = a1[r]; Lw[(4 * q + r) * 48 + 32 + i] = a2[r]; }
                __syncthreads();
                if (kh == 0 && lane < 16) {
                    const int tok = grp * 16 + lane; const float rs = row_rs(ss1, tok);
                    const LAS float* L0 = L + (wave >> 1) * 2 * 768 + lane * 48; const LAS float* L1 = L0 + 768;
                    float lg[36];
#pragma unroll
                    for (int j = 0; j < 36; ++j) lg[j] = (L0[j] + L1[j]) * rs;
                    float mx = -3e38f; int g = 0;
#pragma unroll
                    for (int j = 0; j < 4; ++j) { lg[j] += brg[j]; if (lg[j] > mx) { mx = lg[j]; g = j; } }
                    float sum = 0.f;
#pragma unroll
                    for (int j = 0; j < 4; ++j) sum += __expf(lg[j] - mx);
                    const float pg = 1.f / sum;
                    float el[8], m2 = -3e38f;
#pragma unroll
                    for (int e = 0; e < 8; ++e) { float v = 0.f;
#pragma unroll
                        for (int gg = 0; gg < 4; ++gg) v = (gg == g) ? lg[4 + gg * 8 + e] : v;
                        el[e] = v + bre[g * 8 + e]; m2 = fmaxf(m2, el[e]); }
                    int e1 = 0, e2 = 0; float p1 = -1.f, p2 = -1.f;
#pragma unroll
                    for (int e = 0; e < 8; ++e) { el[e] = __expf(el[e] - m2); if (el[e] > p1) { p1 = el[e]; e1 = e; } }
#pragma unroll
                    for (int e = 0; e < 8; ++e) if (e != e1 && el[e] > p2) { p2 = el[e]; e2 = e; }
                    const float wsum = p1 + p2; const float c1 = pg * (p1 / wsum), c2 = pg * (p2 / wsum);
                    const int ea = e1 < e2 ? e1 : e2, eb = e1 < e2 ? e2 : e1; const float ca = e1 < e2 ? c1 : c2, cb = e1 < e2 ? c2 : c1;
                    const int bucket = g * 28 + (ea * (15 - ea)) / 2 + (eb - ea - 1);
                    const unsigned rank = atomicAdd(cnt + bucket, 1u);
                    ent[(size_t)bucket * T_ + rank] = (u32x4){(unsigned)tok, __float_as_uint(ca), __float_as_uint(cb), __float_as_uint(rs)};
                }
                __syncthreads();
            }
            }
            GRID_BAR();
        }
        if (IN(7)) {
            PHASE_VARS(); LAYER_VARS();
            LAS int* tb = (LAS int*)(lds + MISC_OFF + 6144);
            pg8::moe_build_table(tb, (const unsigned*)(ws + WS_CTL) + CW_CNT + l * 128, wave_s * 64 + lane_opaque());
            pg8::MoeOrder1 S{tb, (const char*)XBn, (const char*)((bf16*)(ws + WS_WGU) + (size_t)l * 32 * 512 * D_), (const u32x4*)(ws + WS_SCR + SC_ENT), G, bx};
            pg8::EpiHid E{(bf16*)(ws + WS_SCR + SC_HIDB), (const u32x4*)(ws + WS_SCR + SC_ENT)};
            REPEAT(7) pg8::gemm_phase<pg8::EpiHid, pg8::MoeOrder1, true, true>(lds + RING_OFF, wave_s, D_, D_, D_, S, E);
            GRID_BAR();
        }
        if (IN(8)) {
            PHASE_VARS(); LAYER_VARS();
            LAS int* tb = (LAS int*)(lds + MISC_OFF + 6144);
            pg8::moe_build_table(tb, (const unsigned*)(ws + WS_CTL) + CW_CNT + l * 128, wave_s * 64 + lane_opaque());
            pg8::MoeOrder2 S{tb, (const char*)(ws + WS_SCR + SC_HIDB), (const char*)((bf16*)(ws + WS_WD) + (size_t)l * 4 * D_ * D_), G, bx};
            REPEAT(8) { pg8::EpiMoe2 E{XBn, rep_ ? DRY_XB(ws) : XBc, rep_ ? DRY_SS(ws) : ss2, (const u32x4*)(ws + WS_SCR + SC_ENT), (LAS float*)(lds + MISC_OFF + 1024)};
            pg8::gemm_phase<pg8::EpiMoe2, pg8::MoeOrder2, false, true>(lds + RING_OFF, wave_s, 512, 512, D_, S, E); }
            GRID_BAR();
        }
        if (IN(9)) {
            PHASE_VARS(); LAYER_VARS();
            pg8::DenseOrder S; S.init(XBc, (bf16*)(ws + WS_WPG) + (size_t)l * D_ * D_, T_, D_, D_, D_, G, bx);
            REPEAT(9) { pg8::EpiPle E{XBc, rep_ ? DRY_XB(ws) : XBn, (const bf16*)(ws + WS_PROJ), ss2, rep_ ? DRY_SS(ws) : ss3, (LAS float*)(lds + MISC_OFF + 1024)};
            pg8::gemm_phase<pg8::EpiPle, pg8::DenseOrder, false, true>(lds + RING_OFF, wave_s, D_, D_, D_, S, E); }
            GRID_BAR();
        }
    }
    if (argp()->do_fin) {
        PHASE_VARS(); WAVE_VARS();
        const float* gf = ap->in[20]; const float* ssf = ssb + (size_t)(DEPTH_ * 3) * 8 * T_; const bf16* XF = (const bf16*)(ws + WS_XB0);
        for (int m = gw; m < T_; m += NGW) { const float rs = row_rs(ssf, m);
#pragma unroll
            for (int j = 0; j < 8; ++j) { const u32x2 xw = *((const u32x2*)(XF + (size_t)m * D_) + lane + 64 * j); const f32x4 g = *((const f32x4*)gf + lane + 64 * j);
                const f32x4 xv = {__uint_as_float(xw.x << 16), __uint_as_float(xw.x & 0xffff0000u), __uint_as_float(xw.y << 16), __uint_as_float(xw.y & 0xffff0000u)};
                *((f32x4*)(X + (size_t)m * D_) + lane + 64 * j) = xv * rs * g; } }
    }
#undef IN
}

static void launch_mk(Args a, int grid, hipStream_t stream) { hipLaunchKernelGGL(mk_fwd, dim3(grid), dim3(NTHR), LDS_BYTES, stream, a); }

extern "C" void kernel_launch(void* const* d_in, const int* in_sizes, int n_in, void* d_out, int out_size, void* d_ws, size_t ws_size, hipStream_t stream) {
    static int grid = 0;
    if (grid == 0) {
        int dev = 0, cus = 0;
        (void)hipGetDevice(&dev); (void)hipDeviceGetAttribute(&cus, hipDeviceAttributeMultiprocessorCount, dev);
        (void)hipFuncSetAttribute((const void*)mk_fwd, hipFuncAttributeMaxDynamicSharedMemorySize, LDS_BYTES);
        grid = cus > 0 ? cus : 256;
        if (ws_size < WS_END) { fprintf(stderr, "workspace too small: %zu < %zu\n", ws_size, (size_t)WS_END); grid = -1; }
    }
    if (grid < 0) return;
    unsigned char* ws = (unsigned char*)d_ws;
    (void)hipMemsetAsync(ws + WS_CTL, 0, CTL_BYTES, stream);
    Args a{};
    for (int i = 0; i < 21; ++i) a.in[i] = (const float*)d_in[i];
    a.out = (float*)d_out; a.ws = ws; a.use_bar = 0; a.mix = 1; a.rep = PROBE_REP; a.pad = 0;
#if defined(MK_MULTI_LAUNCH)
    auto run = [&](int l, int ph, int pro, int fin) { Args b = a; b.l_lo = l; b.l_hi = (ph > 0) ? l + 1 : l; b.ph_lo = ph; b.ph_hi = ph + 1; b.do_pro = pro; b.do_fin = fin; launch_mk(b, grid, stream); };
    a.mix = 7;
    run(0, 0, 1, 0);
    for (int l = 0; l < DEPTH_; ++l) for (int ph = 1; ph <= 9; ++ph) run(l, ph, 0, 0);
    run(0, 0, 0, 1);
#else
    a.mix = 7; a.use_bar = 1; a.l_lo = 0; a.l_hi = DEPTH_; a.ph_lo = 1; a.ph_hi = 10; a.do_pro = 1; a.do_fin = 1;
    launch_mk(a, grid, stream);
#endif
}
```
